# Optimizing an MI355X kernel written in HIP

```python
import math
import jax, jax.numpy as jnp
from jax import lax
import numpy as np

D_MODEL = 1024
BATCH = 1
SEQ = 16384
DEPTH = 2

GRID_W = 64
CTX_LEN = 256
HEAD_DIM = D_MODEL // 16
A_HEADS = 4
A_QK_DIM = HEAD_DIM
A_V_DIM = 2 * HEAD_DIM
A_WIDTH = A_HEADS * A_V_DIM
A_SCALE = A_QK_DIM ** -0.5
B_HEADS = 4
B_HEAD_DIM = HEAD_DIM
B_WIDTH = B_HEADS * B_HEAD_DIM
C_GROUPS = 4
C_GROUP_DIM = HEAD_DIM
C_WIDTH = C_GROUPS * C_GROUP_DIM
MIX_WIDTH = A_WIDTH + B_WIDTH + C_WIDTH
IN_SIZES = (A_WIDTH, A_WIDTH, A_WIDTH, B_WIDTH, B_WIDTH, B_WIDTH, B_WIDTH, 4 * B_HEADS, C_WIDTH)
IN_WIDTH = sum(IN_SIZES)
ROPE_BASE = 10000.0
Q_BLOCK = 128
MLSTM_CHUNK = 64
N_EXPERTS = 32
TOP_K = 4
D_EXPERT = D_MODEL
SWIGLU_LIMIT = 7.0
SWIGLU_ALPHA = 1.702
MOE_BLOCK = 128
DEEPNORM_ALPHA = (2 * DEPTH) ** 0.25
DEEPNORM_BETA = (8 * DEPTH) ** -0.25
EPS = 1e-5

kernel_name = 'hybrid_diffattn_mlstm_fourier_moe_dit'


def layer_norm(x, w, b):
    xf = x.astype(jnp.float32)
    mu = jnp.mean(xf, axis=-1, keepdims=True)
    var = jnp.mean(jnp.square(xf - mu), axis=-1, keepdims=True)
    return ((xf - mu) * lax.rsqrt(var + EPS)).astype(x.dtype) * w + b


def rms_norm_heads(x, w):
    xf = x.astype(jnp.float32)
    y = xf * lax.rsqrt(jnp.mean(jnp.square(xf), axis=-1, keepdims=True) + EPS)
    return y.astype(x.dtype) * w.reshape(x.shape[-2:])


def modulation(vec, w_ada, b_ada):
    m = (jax.nn.silu(vec) @ w_ada + b_ada)[..., None, :]
    return jnp.split(m, 6, axis=-1)


def axial_rope_tables(n_tokens, dtype):
    rows = n_tokens // GRID_W
    row = jnp.broadcast_to(jnp.arange(rows, dtype=jnp.float32)[:, None], (rows, GRID_W)).reshape(-1)
    col = jnp.broadcast_to(jnp.arange(GRID_W, dtype=jnp.float32)[None, :], (rows, GRID_W)).reshape(-1)
    axis_dim = A_QK_DIM // 2
    inv_freq = ROPE_BASE ** (-jnp.arange(0, axis_dim, 2, dtype=jnp.float32) / axis_dim)
    ang_r = row[:, None] * inv_freq
    ang_c = col[:, None] * inv_freq
    ang = jnp.concatenate([ang_r, ang_r, ang_c, ang_c], axis=-1)
    return jnp.cos(ang).astype(dtype), jnp.sin(ang).astype(dtype)


def apply_axial_rope(x, cos, sin):
    xr = x.reshape(x.shape[:-1] + (2, 2, A_QK_DIM // 4))
    rot = jnp.stack([-xr[..., 1, :], xr[..., 0, :]], axis=-2).reshape(x.shape)
    return x * cos + rot * sin


def split_projection(p, gate_bias):
    bsz, n, _ = p.shape
    aq, ak, av, bq, bk, bv, bo, bg, cu = jnp.split(p, np.cumsum(IN_SIZES)[:-1].tolist(), axis=-1)
    pair = lambda t: t.reshape(bsz, n, A_HEADS, 2, A_QK_DIM).transpose(0, 2, 3, 1, 4)
    heads = lambda t, h: t.reshape(bsz, n, h, -1).transpose(0, 2, 1, 3)
    gates = bg.reshape(bsz, n, 4, B_HEADS).transpose(2, 0, 3, 1) + gate_bias[:, None, :, None]
    return (pair(aq), pair(ak), heads(av, A_HEADS), heads(bq, B_HEADS),
            heads(bk, B_HEADS) * (B_HEAD_DIM ** -0.5), heads(bv, B_HEADS), bo, gates, cu)


def diff_attention_block(q, k_all, v_all, lam):
    s = jnp.einsum('bhcqd,bhckd->bhcqk', q, k_all, preferred_element_type=jnp.float32) * A_SCALE
    p = jax.nn.softmax(s, axis=-1)
    a = p[:, :, 0] - lam * p[:, :, 1]
    return jnp.einsum('bhqk,bhkv->bhqv', a.astype(v_all.dtype), v_all)


def diff_head_out(o, norm_w, lam_init):
    bsz, h, n, dv = o.shape
    y = rms_norm_heads(o.transpose(0, 2, 1, 3), norm_w) * (1.0 - lam_init)
    return y.reshape(bsz, n, h * dv)


def mlstm_scan_states(g, m_loc, c_loc, n_loc, state0):
    def step(carry, xs):
        c_prev, n_prev, m_prev = carry
        g_c, m_c, cc, nc_ = xs
        m_new = jnp.maximum(g_c + m_prev, m_c)
        dec = jnp.exp(g_c + m_prev - m_new)
        inj = jnp.exp(m_c - m_new)
        c_new = dec[..., None, None] * c_prev + inj[..., None, None] * cc
        n_new = dec[..., None] * n_prev + inj[..., None] * nc_
        return (c_new, n_new, m_new), (c_prev, n_prev, m_prev)
    xs = tuple(jnp.moveaxis(t, 2, 0) for t in (g, m_loc, c_loc, n_loc))
    final, starts = lax.scan(step, state0, xs)
    return tuple(jnp.moveaxis(t, 0, 2) for t in starts), final


def mlstm_chunk_outputs(q, k, v, i_pre, b, starts):
    c0, n0, m0 = starts
    L = q.shape[3]
    lower = jnp.tril(jnp.ones((L, L), dtype=bool))
    dmat = jnp.where(lower, b[..., :, None] - b[..., None, :] + i_pre[..., None, :], -jnp.inf)
    inter = b + m0[..., None]
    m = jnp.maximum(inter, jnp.max(dmat, axis=-1))
    s = jnp.einsum('bhctk,bhcsk->bhcts', q, k) * jnp.exp(dmat - m[..., None])
    e_inter = jnp.exp(inter - m)
    num = jnp.einsum('bhcts,bhcsv->bhctv', s, v) + e_inter[..., None] * jnp.einsum('bhcvk,bhctk->bhctv', c0, q)
    den = jnp.sum(s, axis=-1) + e_inter * jnp.einsum('bhck,bhctk->bhct', n0, q)
    return num / jnp.maximum(jnp.abs(den), jnp.exp(-m))[..., None]


def mlstm_direction(q, k, v, i_pre, f_pre, state0, with_outputs):
    bsz, h, n, d = k.shape
    nc = n // MLSTM_CHUNK
    chunk = lambda t: t.reshape((bsz, h, nc, MLSTM_CHUNK) + t.shape[3:])
    k, v, i_pre = chunk(k), chunk(v), chunk(i_pre)
    b = jnp.cumsum(chunk(jax.nn.log_sigmoid(f_pre)), axis=-1)
    g = b[..., -1]
    a = g[..., None] - b + i_pre
    m_loc = jnp.max(a, axis=-1)
    w = jnp.exp(a - m_loc[..., None])
    c_loc = jnp.einsum('bhcl,bhclv,bhclk->bhcvk', w, v, k)
    n_loc = jnp.einsum('bhcl,bhclk->bhck', w, k)
    starts, final = mlstm_scan_states(g, m_loc, c_loc, n_loc, state0)
    if not with_outputs:
        return None, final
    h_out = mlstm_chunk_outputs(chunk(q), k, v, i_pre, b, starts)
    return h_out.reshape(bsz, h, n, d), final


def bidirectional_mlstm(lat, g_l, ctx, g_c, need_ctx):
    f32 = jnp.float32
    q_l, k_l, v_l = [t.astype(f32) for t in lat]
    q_c, k_c, v_c = [t.astype(f32) for t in ctx]
    g_l = g_l.astype(f32)
    g_c = g_c.astype(f32)
    bsz = q_l.shape[0]
    state0 = (jnp.zeros((bsz, B_HEADS, B_HEAD_DIM, B_HEAD_DIM), f32),
              jnp.zeros((bsz, B_HEADS, B_HEAD_DIM), f32),
              jnp.zeros((bsz, B_HEADS), f32))
    h_lat, h_ctx = [], []
    for d in range(2):
        seq = (lambda t: t) if d == 0 else (lambda t: jnp.flip(t, axis=2))
        hc, st = mlstm_direction(seq(q_c), seq(k_c), seq(v_c), seq(g_c[d]), seq(g_c[2 + d]), state0, need_ctx)
        hl, _ = mlstm_direction(seq(q_l), seq(k_l), seq(v_l), seq(g_l[d]), seq(g_l[2 + d]), st, True)
        h_lat.append(seq(hl))
        if need_ctx:
            h_ctx.append(seq(hc))
    return h_lat[0] + h_lat[1], ((h_ctx[0] + h_ctx[1]) if need_ctx else None)


def mlstm_head_out(h, o_pre, norm_w):
    bsz, hh, n, d = h.shape
    y = rms_norm_heads(h.transpose(0, 2, 1, 3), norm_w).reshape(bsz, n, hh * d)
    return (y * jax.nn.sigmoid(o_pre.astype(jnp.float32))).astype(o_pre.dtype)


def fourier_mix(u):
    bsz, n, _ = u.shape
    ug = u.reshape(bsz, n, C_GROUPS, C_GROUP_DIM).astype(jnp.float32)
    y = jnp.fft.fft2(ug, axes=(1, 3), norm='ortho').real
    return y.reshape(bsz, n, C_WIDTH).astype(u.dtype)


def token_mixer(h_lat, h_ctx, w_in, gate_bias, diff_lambda, diff_norm_w, mlstm_norm_w, w_out, lam_init, need_ctx):
    bsz, n_lat, _ = h_lat.shape
    aq_l, ak_l, av_l, bq_l, bk_l, bv_l, bo_l, g_l, cu_l = split_projection(h_lat @ w_in, gate_bias)
    aq_c, ak_c, av_c, bq_c, bk_c, bv_c, bo_c, g_c, cu_c = split_projection(h_ctx @ w_in, gate_bias)

    lq1, lk1, lq2, lk2 = diff_lambda.astype(jnp.float32)
    lam = jnp.exp(jnp.sum(lq1 * lk1)) - jnp.exp(jnp.sum(lq2 * lk2)) + lam_init
    cos, sin = axial_rope_tables(n_lat, h_lat.dtype)
    q_l = apply_axial_rope(aq_l, cos, sin)
    k_all = jnp.concatenate([ak_c, apply_axial_rope(ak_l, cos, sin)], axis=3)
    v_all = jnp.concatenate([av_c, av_l], axis=2)
    n_blocks = n_lat // Q_BLOCK
    q_blocks = jnp.moveaxis(q_l.reshape(bsz, A_HEADS, 2, n_blocks, Q_BLOCK, A_QK_DIM), 3, 0)
    o_l = lax.map(lambda qb: diff_attention_block(qb, k_all, v_all, lam), q_blocks)
    o_l = jnp.moveaxis(o_l, 0, 2).reshape(bsz, A_HEADS, n_lat, A_V_DIM)

    h_l, h_c = bidirectional_mlstm((bq_l, bk_l, bv_l), g_l, (bq_c, bk_c, bv_c), g_c, need_ctx)

    out_l = jnp.concatenate([diff_head_out(o_l, diff_norm_w, lam_init),
                             mlstm_head_out(h_l, bo_l, mlstm_norm_w),
                             fourier_mix(cu_l)], axis=-1) @ w_out
    if not need_ctx:
        return out_l, None
    o_c = diff_attention_block(aq_c, ak_c, av_c, lam)
    out_c = jnp.concatenate([diff_head_out(o_c, diff_norm_w, lam_init),
                             mlstm_head_out(h_c, bo_c, mlstm_norm_w),
                             fourier_mix(cu_c)], axis=-1) @ w_out
    return out_l, out_c


def moe_ffn(h, w_router, b_router, w_gate_up, b_gate_up, w_down, b_down):
    shp = h.shape
    t = h.reshape(-1, shp[-1])
    n_tok = t.shape[0]
    logits = (t @ w_router + b_router).astype(jnp.float32)
    top_val, top_idx = lax.top_k(logits, TOP_K)
    gates = jax.nn.softmax(top_val, axis=-1).astype(h.dtype)
    n_asg = n_tok * TOP_K
    e_flat = top_idx.reshape(n_asg)
    tok = jnp.arange(n_asg, dtype=jnp.int32) // TOP_K
    w_flat = gates.reshape(n_asg)
    counts = jnp.bincount(e_flat, length=N_EXPERTS)
    padded = (counts + MOE_BLOCK - 1) // MOE_BLOCK * MOE_BLOCK
    pad_end = jnp.cumsum(padded)
    pad_start = pad_end - padded
    start = jnp.cumsum(counts) - counts
    order = jnp.argsort(e_flat)
    e_sorted = e_flat[order]
    dest = pad_start[e_sorted] + jnp.arange(n_asg, dtype=jnp.int32) - start[e_sorted]
    n_blocks = -(-n_asg // MOE_BLOCK) + N_EXPERTS
    n_rows = n_blocks * MOE_BLOCK
    row_tok = jnp.full((n_rows,), n_tok, jnp.int32).at[dest].set(tok[order])
    row_w = jnp.zeros((n_rows,), h.dtype).at[dest].set(w_flat[order])
    block_exp = jnp.minimum(jnp.searchsorted(pad_end, jnp.arange(n_blocks, dtype=jnp.int32) * MOE_BLOCK, side='right'), N_EXPERTS - 1)
    t_pad = jnp.concatenate([t, jnp.zeros((1, shp[-1]), t.dtype)], axis=0)
    xb = t_pad[row_tok].reshape(n_blocks, MOE_BLOCK, shp[-1])

    def expert_block(args):
        xs, e = args
        gu = xs @ w_gate_up[e] + b_gate_up[e]
        gate = jnp.minimum(gu[:, :D_EXPERT], SWIGLU_LIMIT)
        up = jnp.clip(gu[:, D_EXPERT:], -SWIGLU_LIMIT, SWIGLU_LIMIT)
        act = gate * jax.nn.sigmoid(SWIGLU_ALPHA * gate) * (up + 1.0)
        return act @ w_down[e] + b_down[e]

    yb = lax.map(expert_block, (xb, block_exp)).reshape(n_rows, shp[-1])
    out = jax.ops.segment_sum(yb * row_w[:, None], row_tok, num_segments=n_tok + 1)[:n_tok]
    return out.reshape(shp)


def setup_inputs(seed: int = 0) -> dict:
    key = jax.random.key(seed)
    ks = jax.random.split(key, 22)
    f32 = jnp.float32
    nrm = lambda k, shape, s: jax.random.normal(k, shape, f32) * s
    D = D_MODEL
    gate_base = jnp.concatenate([jnp.zeros((2, B_HEADS), f32),
                                 jnp.broadcast_to(jnp.linspace(3.0, 6.0, B_HEADS, dtype=f32), (2, B_HEADS))], axis=0)
    return {
        'x': nrm(ks[0], (BATCH, SEQ, D), 1.0),
        'c': nrm(ks[1], (BATCH, D), 1.0),
        'ctx': nrm(ks[2], (BATCH, CTX_LEN, D), 1.0),
        'c_ctx': nrm(ks[3], (D,), 1.0),
        'w_ada': nrm(ks[4], (DEPTH, D, 6 * D), 0.5 * D ** -0.5),
        'b_ada': nrm(ks[5], (DEPTH, 6 * D), 0.02),
        'w_in': nrm(ks[6], (DEPTH, D, IN_WIDTH), D ** -0.5),
        'mlstm_gate_bias': gate_base + nrm(ks[7], (DEPTH, 4, B_HEADS), 0.1),
        'diff_lambda': nrm(ks[8], (DEPTH, 4, A_QK_DIM), 0.1),
        'diff_norm_w': 1.0 + nrm(ks[9], (DEPTH, A_WIDTH), 0.02),
        'mlstm_norm_w': 1.0 + nrm(ks[10], (DEPTH, B_WIDTH), 0.02),
        'w_out': nrm(ks[11], (DEPTH, MIX_WIDTH, D), DEEPNORM_BETA * MIX_WIDTH ** -0.5),
        'ln1_w': 1.0 + nrm(ks[12], (DEPTH, D), 0.02),
        'ln1_b': nrm(ks[13], (DEPTH, D), 0.02),
        'w_router': nrm(ks[14], (DEPTH, D, N_EXPERTS), D ** -0.5),
        'b_router': nrm(ks[15], (DEPTH, N_EXPERTS), 0.01),
        'w_gate_up': nrm(ks[16], (DEPTH, N_EXPERTS, D, 2 * D_EXPERT), D ** -0.5),
        'b_gate_up': nrm(ks[17], (DEPTH, N_EXPERTS, 2 * D_EXPERT), 0.02),
        'w_down': nrm(ks[18], (DEPTH, N_EXPERTS, D_EXPERT, D), DEEPNORM_BETA * D_EXPERT ** -0.5),
        'b_down': nrm(ks[19], (DEPTH, N_EXPERTS, D), 0.02),
        'ln2_w': 1.0 + nrm(ks[20], (DEPTH, D), 0.02),
        'ln2_b': nrm(ks[21], (DEPTH, D), 0.02),
    }


def reference(x, c, ctx, c_ctx, w_ada, b_ada, w_in, mlstm_gate_bias, diff_lambda, diff_norm_w,
              mlstm_norm_w, w_out, ln1_w, ln1_b, w_router, b_router, w_gate_up, b_gate_up,
              w_down, b_down, ln2_w, ln2_b):
    n_ctx = ctx.shape[1]
    for l in range(DEPTH):
        need_ctx = l < DEPTH - 1
        lam_init = 0.8 - 0.6 * math.exp(-0.3 * l)
        sh1, sc1, g1, sh2, sc2, g2 = modulation(c, w_ada[l], b_ada[l])
        csh1, csc1, cg1, csh2, csc2, cg2 = modulation(c_ctx, w_ada[l], b_ada[l])
        mix_l, mix_c = token_mixer(x * (1.0 + sc1) + sh1, ctx * (1.0 + csc1) + csh1, w_in[l],
                                   mlstm_gate_bias[l], diff_lambda[l], diff_norm_w[l], mlstm_norm_w[l],
                                   w_out[l], lam_init, need_ctx)
        x = layer_norm(DEEPNORM_ALPHA * x + g1 * mix_l, ln1_w[l], ln1_b[l])
        moe_args = (w_router[l], b_router[l], w_gate_up[l], b_gate_up[l], w_down[l], b_down[l])
        if need_ctx:
            ctx = layer_norm(DEEPNORM_ALPHA * ctx + cg1 * mix_c, ln1_w[l], ln1_b[l])
            f_in = jnp.concatenate([ctx * (1.0 + csc2) + csh2, x * (1.0 + sc2) + sh2], axis=1)
            f_out = moe_ffn(f_in, *moe_args)
            f_lat = f_out[:, n_ctx:]
            ctx = layer_norm(DEEPNORM_ALPHA * ctx + cg2 * f_out[:, :n_ctx], ln2_w[l], ln2_b[l])
        else:
            f_lat = moe_ffn(x * (1.0 + sc2) + sh2, *moe_args)
        x = layer_norm(DEEPNORM_ALPHA * x + g2 * f_lat, ln2_w[l], ln2_b[l])
    return x
```

```cpp
#include <hip/hip_runtime.h>
#include <cstdio>
#include <cstdint>
#include <cmath>

#ifndef MK_SINGLE
#define MK_SINGLE 1
#endif

constexpr int D = 1024, SEQ = 16384, NCTX = 256, T = SEQ + NCTX, DEPTH = 2, INW = 2832;
constexpr int NE = 32, TOPK = 4, NCH = 260;
constexpr int SLOT_ROWS = 74752;
constexpr float LN_EPS = 1e-5f;
constexpr float DN_ALPHA = 1.41421356237f;
constexpr float QSCALE = 0.125f * 1.44269504089f;

#define GAS __attribute__((address_space(1)))
#define LAS __attribute__((address_space(3)))
typedef unsigned short bf16;
typedef unsigned v4u __attribute__((ext_vector_type(4)));
typedef unsigned v2u __attribute__((ext_vector_type(2)));
typedef float f32x4 __attribute__((ext_vector_type(4)));
typedef float f32x16 __attribute__((ext_vector_type(16)));
typedef short bf16x8 __attribute__((ext_vector_type(8)));
typedef short s16x4 __attribute__((ext_vector_type(4)));
typedef GAS unsigned gu32;
#define RLX_AGENT __ATOMIC_RELAXED, __HIP_MEMORY_SCOPE_AGENT
#define LDS_WAIT() asm volatile("s_waitcnt lgkmcnt(0)" ::: "memory")
#define VM_WAIT() asm volatile("s_waitcnt vmcnt(0)" ::: "memory")

typedef __bf16 bf2_t __attribute__((ext_vector_type(2)));
__device__ __forceinline__ unsigned f2bf(float f) { return (unsigned)__builtin_bit_cast(unsigned short, (__bf16)f); }
__device__ __forceinline__ unsigned pk2(float lo, float hi) { bf2_t v = {(__bf16)lo, (__bf16)hi}; return __builtin_bit_cast(unsigned, v); }
__device__ __forceinline__ float bf_lo(unsigned u) { return __builtin_bit_cast(float, u << 16); }
__device__ __forceinline__ float bf_hi(unsigned u) { return __builtin_bit_cast(float, u & 0xffff0000u); }
__device__ __forceinline__ float shx(float v, int lane, int mask) { return __builtin_bit_cast(float, __builtin_amdgcn_ds_bpermute((lane ^ mask) << 2, __builtin_bit_cast(int, v))); }
__device__ __forceinline__ int shxi(int v, int lane, int mask) { return __builtin_amdgcn_ds_bpermute((lane ^ mask) << 2, v); }
__device__ __forceinline__ float shup(float v, int lane, int d) { return __builtin_bit_cast(float, __builtin_amdgcn_ds_bpermute((lane - d) << 2, __builtin_bit_cast(int, v))); }
__device__ __forceinline__ float wave_sum(float v, int lane) {
#pragma unroll
    for (int o = 1; o < 64; o <<= 1) v += shx(v, lane, o);
    return v;
}
__device__ __forceinline__ float wave_max(float v, int lane) {
#pragma unroll
    for (int o = 1; o < 64; o <<= 1) v = fmaxf(v, shx(v, lane, o));
    return v;
}
template <int CTRL, int RM, int BM>
__device__ __forceinline__ float dpp0(float v) { return __builtin_bit_cast(float, __builtin_amdgcn_update_dpp(0, __builtin_bit_cast(int, v), CTRL, RM, BM, true)); }
template <int CTRL, int RM, int BM>
__device__ __forceinline__ float dppo(float old, float v) { return __builtin_bit_cast(float, __builtin_amdgcn_update_dpp(__builtin_bit_cast(int, old), __builtin_bit_cast(int, v), CTRL, RM, BM, false)); }
__device__ __forceinline__ float wave_sum_u(float v) {
    v += dpp0<0x111, 0xf, 0xf>(v); v += dpp0<0x112, 0xf, 0xf>(v); v += dpp0<0x114, 0xf, 0xf>(v); v += dpp0<0x118, 0xf, 0xf>(v);
    v += dpp0<0x142, 0xa, 0xf>(v); v += dpp0<0x143, 0xc, 0xf>(v);
    return __builtin_bit_cast(float, __builtin_amdgcn_readlane(__builtin_bit_cast(int, v), 63));
}
__device__ __forceinline__ float wave_scan_sum(float v) {
    v += dpp0<0x111, 0xf, 0xf>(v); v += dpp0<0x112, 0xf, 0xf>(v); v += dpp0<0x114, 0xf, 0xf>(v); v += dpp0<0x118, 0xf, 0xf>(v);
    v += dpp0<0x142, 0xa, 0xf>(v); v += dpp0<0x143, 0xc, 0xf>(v);
    return v;
}
__device__ __forceinline__ float wave_scan_max(float v) {
    const float ninf = -INFINITY;
    v = fmaxf(v, dppo<0x111, 0xf, 0xf>(ninf, v)); v = fmaxf(v, dppo<0x112, 0xf, 0xf>(ninf, v)); v = fmaxf(v, dppo<0x114, 0xf, 0xf>(ninf, v)); v = fmaxf(v, dppo<0x118, 0xf, 0xf>(ninf, v));
    v = fmaxf(v, dppo<0x142, 0xa, 0xf>(ninf, v)); v = fmaxf(v, dppo<0x143, 0xc, 0xf>(ninf, v));
    return v;
}
#define SWAP32(a, b) asm volatile("s_nop 1\n\tv_permlane32_swap_b32 %0, %1" : "+v"(a), "+v"(b))
#define SWAP16(a, b) asm volatile("s_nop 1\n\tv_permlane16_swap_b32 %0, %1" : "+v"(a), "+v"(b))
typedef float f32x2 __attribute__((ext_vector_type(2)));
__device__ __forceinline__ float sigmoidf_(float x) { return 1.0f / (1.0f + __expf(-x)); }
__device__ __forceinline__ float logsigmoidf_(float x) { return fminf(x, 0.f) - log1pf(expf(-fabsf(x))); }

constexpr size_t al(size_t x) { return (x + 0xFFFFF) & ~(size_t)0xFFFFF; }
constexpr size_t WS_CTL = 0, CTL_ZERO_BYTES = 1u << 20;
constexpr size_t WS_MOD   = WS_CTL + CTL_ZERO_BYTES;
constexpr size_t WS_ROPE  = WS_MOD + al((size_t)2 * 2 * 6144 * 4);
constexpr size_t WS_WGT   = WS_ROPE + al((size_t)256 * 16 * 2 * 4);
constexpr size_t WS_WRT   = WS_WGT + al((size_t)2 * 16 * 1024 * 4);
constexpr size_t WS_WIN   = WS_WRT + al((size_t)2 * 32 * 1024 * 4);
constexpr size_t WS_WV    = WS_WIN + al((size_t)2 * 2560 * 1024 * 2);
constexpr size_t WS_WOUT  = WS_WV + al((size_t)2 * 512 * 1024 * 2);
constexpr size_t WS_WGU   = WS_WOUT + al((size_t)2 * 1024 * 1024 * 2);
constexpr size_t WS_WDN   = WS_WGU + al((size_t)2 * 32 * 2048 * 1024 * 2);
constexpr size_t WS_X     = WS_WDN + al((size_t)2 * 32 * 1024 * 1024 * 2);
constexpr size_t WS_H     = WS_X + al((size_t)T * D * 4);
constexpr size_t WS_QB    = WS_H + al((size_t)T * D * 2);
constexpr size_t WS_KB    = WS_QB + al((size_t)8 * T * 64 * 2);
constexpr size_t WS_VT    = WS_KB + al((size_t)8 * T * 64 * 2);
constexpr size_t WS_MQ    = WS_VT + al((size_t)512 * T * 2);
constexpr size_t SEGB     = al((size_t)T * 256 * 4);
constexpr size_t WS_GATES = WS_MQ + 6 * SEGB;
constexpr size_t WS_BRE   = WS_GATES + al((size_t)T * 16 * 4);
constexpr size_t WS_BIM   = WS_BRE + al((size_t)SEQ * 256 * 4);
constexpr size_t WS_AOUT  = WS_BIM + al((size_t)SEQ * 256 * 4);
constexpr size_t WS_MIX   = WS_AOUT + al((size_t)T * D * 2);
constexpr size_t WS_CL    = WS_MIX + al((size_t)T * D * 4);
constexpr size_t WS_C0    = WS_CL + al((size_t)8 * NCH * 4160 * 4);
constexpr size_t WS_SCAL  = WS_C0 + al((size_t)8 * NCH * 4160 * 4);
constexpr size_t WS_F     = WS_SCAL + al((size_t)8 * NCH * 4 * 4);
constexpr size_t WS_TOKG  = WS_F + al((size_t)T * D * 2);
constexpr size_t WS_ELIST = WS_TOKG + al((size_t)T * 4 * 4);
constexpr size_t WS_SASG  = WS_ELIST + al((size_t)NE * T * 4);
constexpr size_t WS_SG    = WS_SASG + al((size_t)SLOT_ROWS * 4);
constexpr size_t WS_XG    = WS_SG + al((size_t)SLOT_ROWS * 4);
constexpr size_t WS_ACT   = WS_XG + al((size_t)SLOT_ROWS * D * 2);
constexpr size_t WS_YB    = WS_ACT + al((size_t)SLOT_ROWS * D * 2);
constexpr size_t WS_SROW  = WS_YB + al((size_t)SLOT_ROWS * D * 2);
constexpr size_t WS_TSLOT = WS_SROW + al((size_t)SLOT_ROWS * 4);
constexpr size_t WS_FTAB  = WS_TSLOT + al((size_t)T * 4 * 4);
constexpr size_t WS_END   = WS_FTAB + al((size_t)(2 * 64 * 64 + 2 * 128 * 128) * 2);
constexpr int CW_CNT = 64;
constexpr int CW_BAR = 8192;
constexpr int CW_KINF = 16;
constexpr int RING_BYTES = 131072, TAB_OFF = RING_BYTES, MISC_OFF = RING_BYTES + 2048, LDS_BYTES = 147456;

struct Args {
    const float* in[22]; float* out; unsigned char* ws; int ph_lo, ph_hi;
};
enum { I_X = 0, I_C, I_CTX, I_CCTX, I_WADA, I_BADA, I_WIN, I_GBIAS, I_DLAM, I_DNW, I_MNW, I_WOUT, I_LN1W, I_LN1B, I_WR, I_BR, I_WGU, I_BGU, I_WD, I_BD, I_LN2W, I_LN2B };
#define XB_TMO      128
#define XB_XCNT(j)  (256  + 64 * (j))
#define XB_XSUB(j)  (1280 + 64 * (j))
#define XB_XGEN(j)  (2304 + 64 * (j))
#define XB_TOP      3328
#define XB_TOPGEN   3392
#define XCD_BAR_WORDS 3456
#define XB_SPIN_CAP (1u << 18)

__device__ __forceinline__ unsigned xb_ld(unsigned* p)              { return __hip_atomic_load(p, __ATOMIC_RELAXED, __HIP_MEMORY_SCOPE_AGENT); }
__device__ __forceinline__ unsigned xb_add(unsigned* p, unsigned v) { return __hip_atomic_fetch_add(p, v, __ATOMIC_RELAXED, __HIP_MEMORY_SCOPE_AGENT); }
__device__ __forceinline__ unsigned xb_xcc_id() { return (unsigned)__builtin_amdgcn_s_getreg((3 << 11) | 20) & 0xFu; }
#define XB_SPIN(cond, bar) do { unsigned _sp = 0; while (cond) { __builtin_amdgcn_s_sleep(1); \
    if ((++_sp & 255u) == 0u) { if (xb_ld(&(bar)[XB_TMO])) break; if (_sp > XB_SPIN_CAP) { atomicAdd(&(bar)[XB_TMO], 1u); break; } } } } while (0)

struct XcdBarrier {
    unsigned* bar; unsigned x;
    volatile LAS unsigned* st;
};

__device__ __forceinline__ XcdBarrier xcd_barrier_post(unsigned* bar, volatile LAS unsigned* st) {
    XcdBarrier b; b.bar = bar; b.x = xb_xcc_id(); b.st = st;
    if (threadIdx.x == 0) (void)xb_add(&bar[XB_XCNT(b.x)], 1u);
    return b;
}
__device__ __forceinline__ void xcd_barrier_complete(unsigned* bar, unsigned x, unsigned& nloc, unsigned& nx) {
    const unsigned G = gridDim.x * gridDim.y * gridDim.z;
    unsigned sum, cnt, mine, sp = 0u;
    for (;;) {
        sum = 0u; cnt = 0u; mine = 0u;
#pragma unroll
        for (unsigned j = 0; j < 16; ++j) { const unsigned c = xb_ld(&bar[XB_XCNT(j)]); sum += c; cnt += (c > 0u) ? 1u : 0u; mine = (j == x) ? c : mine; }
        if (sum == G) break;
        __builtin_amdgcn_s_sleep(1);
        if ((++sp & 255u) == 0u) { if (xb_ld(&bar[XB_TMO])) break; if (sp > XB_SPIN_CAP) { atomicAdd(&bar[XB_TMO], 1u); break; } }
    }
    nloc = mine > 0u ? mine : 1u; nx = cnt > 0u ? cnt : 1u;
}

__device__ __forceinline__ void xcd_barrier(const XcdBarrier& b, const int tid) {
    asm volatile("s_waitcnt vmcnt(0)" ::: "memory");
    __syncthreads();
    if (tid == 0) {
        unsigned* bar = b.bar;
        __builtin_amdgcn_s_waitcnt(0);
        unsigned nloc = b.st[0], nx = b.st[1];
        if (nloc == 0u) { xcd_barrier_complete(bar, b.x, nloc, nx); b.st[0] = nloc; b.st[1] = nx; }
        const unsigned old = xb_add(&bar[XB_XSUB(b.x)], 1u);
        const unsigned gen = old / nloc;
        if (old + 1u == (gen + 1u) * nloc) {
            __builtin_amdgcn_fence(__ATOMIC_RELEASE, "agent");
            asm volatile("s_waitcnt vmcnt(0)" ::: "memory");
            const unsigned og = xb_add(&bar[XB_TOP], 1u);
            const unsigned tg = og / nx;
            if (og + 1u == (tg + 1u) * nx) xb_add(&bar[XB_TOPGEN], 1u);
            else XB_SPIN(xb_ld(&bar[XB_TOPGEN]) == tg, bar);
            __builtin_amdgcn_fence(__ATOMIC_ACQUIRE, "agent");
            xb_add(&bar[XB_XGEN(b.x)], 1u);
            asm volatile("s_waitcnt vmcnt(0)" ::: "memory");
        } else {
            XB_SPIN(xb_ld(&bar[XB_XGEN(b.x)]) == gen, bar);
            __builtin_amdgcn_fence(__ATOMIC_ACQUIRE, "agent");
            asm volatile("s_waitcnt vmcnt(0)" ::: "memory");
        }
    }
    __syncthreads();
}
namespace pg8 {
#define PG8_LAS __attribute__((address_space(3)))
typedef unsigned short bf16_t;
typedef short bf16x8 __attribute__((ext_vector_type(8)));
typedef float f32x4 __attribute__((ext_vector_type(4)));
typedef unsigned u32x4 __attribute__((ext_vector_type(4)));
constexpr int BM = 256, BK = 64, HALF = 128, HTB = HALF * BK * 2  , STAGE_BYTES = 8 * HTB, NXCD = 8, WGM = 8;

__host__ __device__ __forceinline__ int lds_byte(int r, int c) { const int st = (r >> 4) * 2 + (c >> 5), rr = r & 15, cc = c & 31, ob = rr * 64 + cc * 2; return st * 1024 + (ob ^ (((ob >> 9) & 1) << 5)); }
__host__ __device__ __forceinline__ void stage_rc(int b, int& R, int& C) { const int st = b / 1024, sb = b % 1024, swz = sb ^ (((sb >> 9) & 1) << 5); R = (st >> 1) * 16 + swz / 64; C = (st & 1) * 32 + (swz % 64) / 2; }
__host__ __device__ __forceinline__ int perm32(int rho) { const int n = rho >> 4, i = rho & 15; return 8 * (i >> 2) + 4 * n + (i & 3); }

struct Unit { int pm, pn, ty = 0; };
struct Gemm { const bf16_t* A; const bf16_t* Bt; int M, N, K; const int* gather = nullptr; const bf16_t* A2 = nullptr; const bf16_t* Bt2 = nullptr; };

struct StaticOrder {
    int nM, nN, nwg, G, c;
    __host__ __device__ void init(int M, int N, int G_, int c_) { nM = M / BM; nN = N / BM; nwg = nM * nN; G = G_; c = c_; }
    __host__ __device__ bool next(int i, Unit& u) const { const long L = (long)i * G + c; if (L >= nwg) return false; map((int)L, u); return true; }
    __host__ __device__ bool map(int L, Unit& u) const {
        int wgid = L; { const int q = nwg / NXCD, r = nwg % NXCD, xcd = wgid % NXCD, off = wgid / NXCD; wgid = (xcd < r ? xcd * (q + 1) : r * (q + 1) + (xcd - r) * q) + off; }
        const int nig = WGM * nN, gid = wgid / nig, fm = gid * WGM, gsz = (nM - fm) < WGM ? (nM - fm) : WGM;
        u.pm = fm + ((wgid % nig) % gsz); u.pn = (wgid % nig) / gsz; return true;
    }
    __device__ __forceinline__ void a_ready(const Unit&) const {}
    __device__ __forceinline__ void done(const Unit&) const {}
};

__device__ __forceinline__ unsigned cvt_pk_bf16(float lo, float hi) { unsigned r; asm volatile("v_cvt_pk_bf16_f32 %0, %1, %2" : "=v"(r) : "v"(lo), "v"(hi)); return r; }
typedef float f32x2 __attribute__((ext_vector_type(2)));
template <class Epi, class Sched, bool ALIGN_EPI = false, bool SP2 = false, bool GATHER = false>
__device__ __forceinline__ void gemm_phase(PG8_LAS unsigned char* lds, const Gemm g, const Sched& S, const Epi& E, const int tid_in) {
    const int tid = tid_in, wid = __builtin_amdgcn_readfirstlane(tid >> 6), lane = tid & 63, wr = wid >> 2, wc = wid & 3, fr = lane & 15, fq = lane >> 4;
    const int K = g.K, nt = K / BK;
    unsigned voffA[2], voffB[2];
    int gR[2], gC[2];
#pragma unroll
    for (int i = 0; i < 2; ++i) { int R, C; stage_rc(tid * 16 + i * 8192, R, C); const int Rb = Epi::PERM ? ((R & ~31) + perm32(R & 31)) : R; gR[i] = R; gC[i] = C;
        voffA[i] = (unsigned)(R * K + C) * 2u; voffB[i] = (unsigned)(Rb * K + C) * 2u; }
    unsigned offC[2][2], offN[2][2];
#define PG8_GOFF(dst, u) do { _Pragma("unroll") for (int h_ = 0; h_ < 2; ++h_) _Pragma("unroll") for (int i_ = 0; i_ < 2; ++i_) \
        (dst)[h_][i_] = (unsigned)g.gather[(u).pm * BM + h_ * HALF + gR[i_]] * (unsigned)(K * 2) + (unsigned)gC[i_] * 2u; } while (0)
    const size_t kstep = (size_t)(BK * 2);
    const size_t hstep = (size_t)HALF * K * 2;
    const size_t tstep = 2 * hstep;
    const unsigned ldsw = (unsigned)wid * 1024u;
    const int aoff = lds_byte(wr * 64 + fr, fq * 8), boff = lds_byte(wc * 32 + fr, fq * 8);
#define PG8_SA(b, h) (((b) * 2 + (h)) * HTB)
#define PG8_SB(b, h) ((4 + (b) * 2 + (h)) * HTB)
#define PG8_STAGE(bufoff, gbase, voff) do { _Pragma("unroll") for (int _i = 0; _i < 2; ++_i) \
        __builtin_amdgcn_global_load_lds((const unsigned*)((const char*)(gbase) + (voff)[_i]), (PG8_LAS unsigned*)(lds + (bufoff) + ldsw + _i * 8192), 16, 0, 0); } while (0)
#define PG8_LDA(dst, b, h) do { _Pragma("unroll") for (int m = 0; m < 4; ++m) _Pragma("unroll") for (int k = 0; k < 2; ++k) dst[m][k] = *(const PG8_LAS bf16x8*)(lds + PG8_SA(b, h) + aoff + m * 2048 + k * 1024); } while (0)
#define PG8_LDB(dst, b, h) do { _Pragma("unroll") for (int n = 0; n < 2; ++n) _Pragma("unroll") for (int k = 0; k < 2; ++k) dst[n][k] = *(const PG8_LAS bf16x8*)(lds + PG8_SB(b, h) + boff + n * 2048 + k * 1024); } while (0)
#define PG8_MMA(ai, bj, At, Bt) do { __builtin_amdgcn_s_setprio(1); _Pragma("unroll") for (int m = 0; m < 4; ++m) _Pragma("unroll") for (int n = 0; n < 2; ++n) _Pragma("unroll") for (int k = 0; k < 2; ++k) \
        acc[ai][bj][m][n] = __builtin_amdgcn_mfma_f32_16x16x32_bf16(Bt[n][k], At[m][k], acc[ai][bj][m][n], 0, 0, 0); __builtin_amdgcn_s_setprio(0); } while (0)
#define PG8_WAIT_V(n) asm volatile("s_waitcnt vmcnt(" #n ")" ::: "memory")
#define PG8_WAIT_L(n) asm volatile("s_waitcnt lgkmcnt(" #n ")" ::: "memory")
#define PG8_BAR __builtin_amdgcn_s_barrier()
#define PG8_SCHED __builtin_amdgcn_sched_barrier(0)
    Unit cur, nxt; int ui = 0;
    if (!S.next(0, cur)) return;
    f32x4 acc[2][2][4][2];
#pragma unroll
    for (int a = 0; a < 2; ++a)
#pragma unroll
        for (int b = 0; b < 2; ++b)
#pragma unroll
            for (int m = 0; m < 4; ++m)
#pragma unroll
                for (int n = 0; n < 2; ++n) acc[a][b][m][n] = (f32x4){0.f, 0.f, 0.f, 0.f};
    bf16x8 At[4][2], B0[2][2], B1[2][2];
    const char* cA = GATHER ? (const char*)g.A : (const char*)(cur.ty ? g.A2 : g.A) + (size_t)cur.pm * tstep; const char* cB = (const char*)(cur.ty ? g.Bt2 : g.Bt) + (size_t)cur.pn * tstep;
    if constexpr (GATHER) PG8_GOFF(offC, cur);
    S.a_ready(cur);
#define PG8_OA(h) (GATHER ? offC[h] : voffA)
#define PG8_HS(h) (GATHER ? (size_t)0 : (size_t)(h) * hstep)
    if constexpr (SP2) {
        PG8_STAGE(PG8_SB(0, 0), cB, voffB); PG8_STAGE(PG8_SB(0, 1), cB + hstep, voffB); PG8_STAGE(PG8_SA(0, 0), cA, PG8_OA(0)); PG8_STAGE(PG8_SA(0, 1), cA + PG8_HS(1), PG8_OA(1));
        if (wr == 1) PG8_BAR;
        PG8_WAIT_V(2); PG8_BAR;
        PG8_STAGE(PG8_SB(1, 0), cB + kstep, voffB); PG8_STAGE(PG8_SA(1, 0), cA + kstep, PG8_OA(0)); PG8_STAGE(PG8_SB(1, 1), cB + hstep + kstep, voffB);
        PG8_WAIT_V(6); PG8_BAR;
    } else {
        PG8_STAGE(PG8_SB(0, 0), cB, voffB); PG8_STAGE(PG8_SA(0, 0), cA, voffA); PG8_STAGE(PG8_SB(0, 1), cB + hstep, voffB); PG8_STAGE(PG8_SA(0, 1), cA + hstep, voffA);
        if (wr == 1) PG8_BAR;
        PG8_WAIT_V(4); PG8_BAR;
        PG8_STAGE(PG8_SB(1, 0), cB + kstep, voffB); PG8_STAGE(PG8_SA(1, 0), cA + kstep, voffA); PG8_STAGE(PG8_SB(1, 1), cB + hstep + kstep, voffB);
        PG8_WAIT_V(6); PG8_BAR;
    }
    for (;;) {
        const bool has_next = S.next(ui + 1, nxt);
        const char* nA = GATHER ? cA : (has_next ? (const char*)(nxt.ty ? g.A2 : g.A) + (size_t)nxt.pm * tstep : cA); const char* nB = has_next ? (const char*)(nxt.ty ? g.Bt2 : g.Bt) + (size_t)nxt.pn * tstep : cB;
        if constexpr (GATHER) { if (has_next) PG8_GOFF(offN, nxt); else {
#pragma unroll
            for (int h_ = 0; h_ < 2; ++h_)
#pragma unroll
                for (int i_ = 0; i_ < 2; ++i_) offN[h_][i_] = offC[h_][i_]; } }
        for (int t = 0; t < nt; t += 2) {
            const bool last = (t == nt - 2);
            const char* a1 = cA + (size_t)(t + 1) * kstep;
            const char* a2 = last ? nA : cA + (size_t)(t + 2) * kstep; const char* b2 = last ? nB : cB + (size_t)(t + 2) * kstep;
            unsigned oN0[2], oN1[2];
#pragma unroll
            for (int i_ = 0; i_ < 2; ++i_) { if constexpr (GATHER) { oN0[i_] = last ? offN[0][i_] : offC[0][i_]; oN1[i_] = last ? offN[1][i_] : offC[1][i_]; } else { oN0[i_] = voffA[i_]; oN1[i_] = voffA[i_]; } }
            const char* a3 = a2 + kstep; const char* b3 = b2 + kstep;
            if (last && has_next) S.a_ready(nxt);
            if constexpr (SP2) {
            PG8_LDB(B0, 0, 0); PG8_LDB(B1, 0, 1); PG8_SCHED; PG8_LDA(At, 0, 0); PG8_STAGE(PG8_SA(1, 1), a1 + PG8_HS(1), PG8_OA(1));
            PG8_WAIT_V(8); PG8_WAIT_L(0); PG8_BAR; PG8_MMA(0, 0, At, B0); PG8_MMA(0, 1, At, B1); PG8_BAR; PG8_SCHED;
            PG8_LDA(At, 0, 1); PG8_STAGE(PG8_SB(0, 0), b2, voffB); PG8_STAGE(PG8_SB(0, 1), b2 + hstep, voffB); PG8_STAGE(PG8_SA(0, 0), a2, oN0);
            PG8_WAIT_V(8); PG8_WAIT_L(0); PG8_BAR; PG8_MMA(1, 0, At, B0); PG8_MMA(1, 1, At, B1); PG8_BAR; PG8_SCHED;
            PG8_LDB(B0, 1, 0); PG8_LDB(B1, 1, 1); PG8_SCHED; PG8_LDA(At, 1, 0); PG8_STAGE(PG8_SA(0, 1), a2 + PG8_HS(1), oN1);
            PG8_WAIT_V(8); PG8_WAIT_L(0); PG8_BAR; PG8_MMA(0, 0, At, B0); PG8_MMA(0, 1, At, B1); PG8_BAR; PG8_SCHED;
            PG8_LDA(At, 1, 1); PG8_STAGE(PG8_SB(1, 0), b3, voffB); PG8_STAGE(PG8_SB(1, 1), b3 + hstep, voffB); PG8_STAGE(PG8_SA(1, 0), a3, oN0);
            PG8_WAIT_V(8); PG8_WAIT_L(0); PG8_BAR; PG8_MMA(1, 0, At, B0); PG8_MMA(1, 1, At, B1); PG8_BAR; PG8_SCHED;
            } else {
            PG8_LDB(B0, 0, 0); PG8_SCHED; PG8_LDA(At, 0, 0); PG8_STAGE(PG8_SA(1, 1), a1 + hstep, voffA);
            PG8_WAIT_L(8); PG8_BAR; PG8_WAIT_L(0); PG8_MMA(0, 0, At, B0); PG8_BAR; PG8_SCHED;
            PG8_LDB(B1, 0, 1); PG8_STAGE(PG8_SB(0, 0), b2, voffB);
            PG8_BAR; PG8_WAIT_L(0); PG8_MMA(0, 1, At, B1); PG8_BAR;
            PG8_LDA(At, 0, 1); PG8_STAGE(PG8_SA(0, 0), a2, voffA);
            PG8_BAR; PG8_WAIT_L(0); PG8_MMA(1, 0, At, B0); PG8_BAR; PG8_SCHED;
            PG8_STAGE(PG8_SB(0, 1), b2 + hstep, voffB);
            PG8_WAIT_V(6); PG8_BAR; PG8_MMA(1, 1, At, B1); PG8_BAR;
            PG8_LDB(B0, 1, 0); PG8_SCHED; PG8_LDA(At, 1, 0); PG8_STAGE(PG8_SA(0, 1), a2 + hstep, voffA);
            PG8_WAIT_L(8); PG8_BAR; PG8_WAIT_L(0); PG8_MMA(0, 0, At, B0); PG8_BAR; PG8_SCHED;
            PG8_LDB(B1, 1, 1); PG8_STAGE(PG8_SB(1, 0), b3, voffB);
            PG8_BAR; PG8_WAIT_L(0); PG8_MMA(0, 1, At, B1); PG8_BAR;
            PG8_LDA(At, 1, 1); PG8_STAGE(PG8_SA(1, 0), a3, voffA);
            PG8_BAR; PG8_WAIT_L(0); PG8_MMA(1, 0, At, B0); PG8_BAR; PG8_SCHED;
            PG8_STAGE(PG8_SB(1, 1), b3 + hstep, voffB);
            PG8_WAIT_V(6); PG8_BAR; PG8_MMA(1, 1, At, B1); PG8_BAR;
            }
        }
        if constexpr (ALIGN_EPI) { if (wr == 0) PG8_BAR; }
        if constexpr (!Epi::AFTER_DRAIN) { E(acc, cur, wr, wc, fr, fq); S.done(cur); }
        if (!has_next) break;
#pragma unroll
        for (int a = 0; a < 2; ++a)
#pragma unroll
            for (int b = 0; b < 2; ++b)
#pragma unroll
                for (int m = 0; m < 4; ++m)
#pragma unroll
                    for (int n = 0; n < 2; ++n) acc[a][b][m][n] = (f32x4){0.f, 0.f, 0.f, 0.f};
        cur = nxt; cA = nA; cB = nB; ++ui;
        if constexpr (GATHER) {
#pragma unroll
            for (int h_ = 0; h_ < 2; ++h_)
#pragma unroll
                for (int i_ = 0; i_ < 2; ++i_) offC[h_][i_] = offN[h_][i_]; }
        if constexpr (ALIGN_EPI) { if (wr == 1) PG8_BAR; }
    }
    PG8_WAIT_V(0);
    if constexpr (!ALIGN_EPI) { if (wr == 0) PG8_BAR; }
    PG8_BAR;
    if constexpr (Epi::AFTER_DRAIN) { E.fused(acc, cur, wr, wc, fr, fq, lds, wid, lane); S.done(cur); }
#undef PG8_SA
#undef PG8_OA
#undef PG8_HS
#undef PG8_GOFF
#undef PG8_SB
#undef PG8_STAGE
#undef PG8_LDA
#undef PG8_LDB
#undef PG8_MMA
#undef PG8_WAIT_V
#undef PG8_WAIT_L
#undef PG8_BAR
#undef PG8_SCHED
}
}

namespace pg8 {
struct EpiInProj {
    static constexpr bool PERM = false, AFTER_DRAIN = false;
    bf16_t* QB; bf16_t* KB; float* SEG; const float* rope; unsigned* kinf;
    __device__ __forceinline__ void operator()(const f32x4 (&acc)[2][2][4][2], const Unit& u, int wr, int wc, int fr, int fq) const {
        const int pn = u.pn;
        if (pn < 4) {
            const bool isq = pn < 2; unsigned char* dst = (unsigned char*)(isq ? QB : KB); const float sc = isq ? QSCALE * 4.0f : 0.25f;
            const int axis = wc & 1;
            float amax0 = 0.f, amax1 = 0.f;
#pragma unroll
            for (int ai = 0; ai < 2; ++ai)
#pragma unroll
                for (int m = 0; m < 4; ++m) {
                    const int row = u.pm * BM + ai * HALF + wr * 64 + m * 16 + fr;
                    asm volatile("" ::: "memory");
                    f32x4 cs0 = {1.f, 1.f, 1.f, 1.f}, sn0 = {0.f, 0.f, 0.f, 0.f};
                    if (row >= NCTX) { const int n = row - NCTX; const int pos = axis ? (n & 63) : (n >> 6);
                        const f32x4* rp = (const f32x4*)(rope + (size_t)(pos * 16 + 4 * fq) * 2);
                        const f32x4 a = rp[0], b = rp[1]; cs0 = (f32x4){a[0], a[2], b[0], b[2]}; sn0 = (f32x4){a[1], a[3], b[1], b[3]}; }
#pragma unroll
                    for (int bj = 0; bj < 2; ++bj) {
                        const int cc = (pn & 1) * 256 + bj * HALF + wc * 32;
                        const int map = cc >> 6, d0 = (cc & 63) + 4 * fq;
                        const f32x4 x0 = acc[ai][bj][m][0], x1 = acc[ai][bj][m][1];
                        const f32x4 o0 = (x0 * cs0 - x1 * sn0) * sc, o1 = (x1 * cs0 + x0 * sn0) * sc;
                        unsigned char* p = dst + ((size_t)map * T + row) * 64 + (cc & 63) + 8 * fq;
                        int w0 = __builtin_amdgcn_cvt_pk_fp8_f32(o0[0], o0[1], 0, false); w0 = __builtin_amdgcn_cvt_pk_fp8_f32(o0[2], o0[3], w0, true);
                        int w1 = __builtin_amdgcn_cvt_pk_fp8_f32(o1[0], o1[1], 0, false); w1 = __builtin_amdgcn_cvt_pk_fp8_f32(o1[2], o1[3], w1, true);
                        *(v2u*)p = (v2u){(unsigned)w0, (unsigned)w1};
                        if (!isq) { float a = (o0[0] * o0[0] + o0[1] * o0[1]) + (o0[2] * o0[2] + o0[3] * o0[3]) + (o1[0] * o1[0] + o1[1] * o1[1]) + (o1[2] * o1[2] + o1[3] * o1[3]);
                            if (bj == 0) amax0 = fmaxf(amax0, a); else amax1 = fmaxf(amax1, a); }
                    }
                }
            if (!isq) {
                amax0 = wave_max(amax0, fr + 16 * fq); amax1 = wave_max(amax1, fr + 16 * fq);
                if (fr == 0 && fq == 0) { const int map0 = ((pn & 1) * 256 + wc * 32) >> 6;
                    atomicMax(kinf + map0 * 2 + axis, __float_as_uint(4.0f * amax0)); atomicMax(kinf + (map0 + 2) * 2 + axis, __float_as_uint(4.0f * amax1)); }
            }
        } else {
            const int seg = pn - 4; bf16_t* dst = (bf16_t*)((char*)SEG + (size_t)seg * SEGB); const float sc = (seg == 1) ? 0.125f : 1.0f;
#pragma unroll
            for (int ai = 0; ai < 2; ++ai)
#pragma unroll
                for (int m = 0; m < 4; ++m) {
                    const int row = u.pm * BM + ai * HALF + wr * 64 + m * 16 + fr;
                    asm volatile("" ::: "memory");
                    bf16_t* rowp = dst + (size_t)row * 256 + wc * 32 + 4 * fq;
#pragma unroll
                    for (int bj = 0; bj < 2; ++bj)
#pragma unroll
                        for (int n = 0; n < 2; ++n) { const f32x4 v = acc[ai][bj][m][n] * sc; *(v2u*)(rowp + bj * HALF + n * 16) = (v2u){pk2(v[0], v[1]), pk2(v[2], v[3])}; }
                }
        }
    }
};
struct EpiVt {
    static constexpr bool PERM = false, AFTER_DRAIN = false;
    bf16_t* VT;
    __device__ __forceinline__ void operator()(const f32x4 (&acc)[2][2][4][2], const Unit& u, int wr, int wc, int fr, int fq) const {
#pragma unroll
        for (int ai = 0; ai < 2; ++ai)
#pragma unroll
            for (int m = 0; m < 4; ++m) {
                const int row = u.pm * BM + ai * HALF + wr * 64 + m * 16 + fr;
                asm volatile("" ::: "memory");
                bf16_t* rowp = VT + (size_t)row * T + u.pn * BM + wc * 32 + 4 * fq;
#pragma unroll
                for (int bj = 0; bj < 2; ++bj)
#pragma unroll
                    for (int n = 0; n < 2; ++n) { const f32x4 v = acc[ai][bj][m][n]; v2u w; w.x = pk2(v[0], v[1]); w.y = pk2(v[2], v[3]); *(v2u*)(rowp + bj * HALF + n * 16) = w; }
            }
    }
};
struct EpiBf16Plain {
    static constexpr bool PERM = false, AFTER_DRAIN = false;
    bf16_t* C; int ldc;
    __device__ __forceinline__ void operator()(const f32x4 (&acc)[2][2][4][2], const Unit& u, int wr, int wc, int fr, int fq) const {
        const int row0 = u.pm * BM + wr * 64 + fr, col0 = u.pn * BM + wc * 32 + 4 * fq;
#pragma unroll
        for (int ai = 0; ai < 2; ++ai)
#pragma unroll
            for (int m = 0; m < 4; ++m) { asm volatile("" ::: "memory"); bf16_t* rowp = C + (size_t)(row0 + ai * HALF + m * 16) * ldc + col0;
#pragma unroll
                for (int bj = 0; bj < 2; ++bj)
#pragma unroll
                    for (int n = 0; n < 2; ++n) { const f32x4 v = acc[ai][bj][m][n]; v2u w; w.x = pk2(v[0], v[1]); w.y = pk2(v[2], v[3]); *(v2u*)(rowp + bj * HALF + n * 16) = w; } }
    }
};
struct EpiNull {
    static constexpr bool PERM = false, AFTER_DRAIN = false;
    float* sink;
    __device__ __forceinline__ void operator()(const f32x4 (&acc)[2][2][4][2], const Unit& u, int wr, int wc, int fr, int fq) const {
        f32x4 s = {0.f, 0.f, 0.f, 0.f};
#pragma unroll
        for (int ai = 0; ai < 2; ++ai)
#pragma unroll
            for (int bj = 0; bj < 2; ++bj)
#pragma unroll
                for (int m = 0; m < 4; ++m)
#pragma unroll
                    for (int n = 0; n < 2; ++n) s += acc[ai][bj][m][n];
        if (s[0] == 1.2345e30f) *(f32x4*)sink = s;
    }
};
struct EpiF32 {
    static constexpr bool PERM = false, AFTER_DRAIN = false;
    float* C; int ldc;
    __device__ __forceinline__ void operator()(const f32x4 (&acc)[2][2][4][2], const Unit& u, int wr, int wc, int fr, int fq) const {
        const int row0 = u.pm * BM + wr * 64 + fr, col0 = u.pn * BM + wc * 32 + 4 * fq;
#pragma unroll
        for (int ai = 0; ai < 2; ++ai)
#pragma unroll
            for (int m = 0; m < 4; ++m) { asm volatile("" ::: "memory"); float* rowp = C + (size_t)(row0 + ai * HALF + m * 16) * ldc + col0;
#pragma unroll
                for (int bj = 0; bj < 2; ++bj)
#pragma unroll
                    for (int n = 0; n < 2; ++n) *(f32x4*)(rowp + bj * HALF + n * 16) = acc[ai][bj][m][n]; }
    }
};
struct EpiSwiglu {
    static constexpr bool PERM = false, AFTER_DRAIN = false;
    bf16_t* ACT; const float* bgu;
    __device__ __forceinline__ void operator()(const f32x4 (&acc)[2][2][4][2], const Unit& u, int wr, int wc, int fr, int fq) const {
        const int e = u.pn >> 3, pnl = u.pn & 7;
        const float* bg = bgu + (size_t)e * 2048;
        f32x4 bgv[2], buv[2];
#pragma unroll
        for (int bj = 0; bj < 2; ++bj) { const int d = pnl * 128 + bj * 64 + wc * 16 + 4 * fq; bgv[bj] = *(const f32x4*)(bg + d); buv[bj] = *(const f32x4*)(bg + 1024 + d); }
#pragma unroll
        for (int ai = 0; ai < 2; ++ai)
#pragma unroll
            for (int m = 0; m < 4; ++m) {
                const int row = u.pm * BM + ai * HALF + wr * 64 + m * 16 + fr;
                asm volatile("" ::: "memory");
#pragma unroll
                for (int bj = 0; bj < 2; ++bj) {
                    const int d = pnl * 128 + bj * 64 + wc * 16 + 4 * fq;
                    const f32x4 g4 = acc[ai][bj][m][0] + bgv[bj], u4 = acc[ai][bj][m][1] + buv[bj];
                    float o[4];
#pragma unroll
                    for (int i = 0; i < 4; ++i) { const float g = fminf(g4[i], 7.0f); const float up = fminf(fmaxf(u4[i], -7.0f), 7.0f);
                        o[i] = g * (1.0f / (1.0f + __expf(-1.702f * g))) * (up + 1.0f); }
                    v2u w; w.x = pk2(o[0], o[1]); w.y = pk2(o[2], o[3]);
                    *(v2u*)(ACT + (size_t)row * D + d) = w;
                }
            }
    }
};
struct EpiDown {
    static constexpr bool PERM = false, AFTER_DRAIN = false;
    bf16_t* YB; const float* bd; const float* sg;
    __device__ __forceinline__ void operator()(const f32x4 (&acc)[2][2][4][2], const Unit& u, int wr, int wc, int fr, int fq) const {
        const int e = u.pn >> 2, pnl = u.pn & 3;
        const int col0 = pnl * 256 + wc * 32 + 4 * fq;
        f32x4 bv[2][2];
#pragma unroll
        for (int bj = 0; bj < 2; ++bj)
#pragma unroll
            for (int n = 0; n < 2; ++n) bv[bj][n] = *(const f32x4*)(bd + (size_t)e * D + col0 + bj * HALF + n * 16);
#pragma unroll
        for (int ai = 0; ai < 2; ++ai)
#pragma unroll
            for (int m = 0; m < 4; ++m) {
                const int row = u.pm * BM + ai * HALF + wr * 64 + m * 16 + fr;
                asm volatile("" ::: "memory");
                const float gw = sg[row];
                bf16_t* rowp = YB + (size_t)row * D + col0;
#pragma unroll
                for (int bj = 0; bj < 2; ++bj)
#pragma unroll
                    for (int n = 0; n < 2; ++n) { const f32x4 v = (acc[ai][bj][m][n] + bv[bj][n]) * gw; v2u w; w.x = pk2(v[0], v[1]); w.y = pk2(v[2], v[3]); *(v2u*)(rowp + bj * HALF + n * 16) = w; }
            }
    }
};
struct InProjOrder {
    StaticOrder s1, s2; int G, c;
    __device__ __forceinline__ bool next(int i, Unit& u) const {
        const int L = i * G + c;
        if (L < s1.nwg) { s1.map(L, u); u.ty = 0; return true; }
        if (L < s1.nwg + s2.nwg) { s2.map(L - s1.nwg, u); u.ty = 1; return true; }
        return false;
    }
    __device__ __forceinline__ void a_ready(const Unit&) const {}
    __device__ __forceinline__ void done(const Unit&) const {}
};
struct EpiInProjAll {
    static constexpr bool PERM = false, AFTER_DRAIN = false;
    EpiInProj e1; EpiVt e2;
    __device__ __forceinline__ void operator()(const f32x4 (&acc)[2][2][4][2], const Unit& u, int wr, int wc, int fr, int fq) const { if (u.ty) e2(acc, u, wr, wc, fr, fq); else e1(acc, u, wr, wc, fr, fq); }
};
struct MoeOrder {
    const volatile PG8_LAS int* up; const volatile PG8_LAS int* mt; const volatile PG8_LAS int* bt; int npn, G, c;
    __device__ __forceinline__ bool next(int i, Unit& u) const {
        const int total = up[32], ch = (total + 7) >> 3, ix = i * (G >> 3) + (c >> 3);
        const int L = (c & 7) * ch + ix;
        if (ix >= ch || L >= total) return false;
        int e = 0;
#pragma unroll 1
        for (int j = 1; j < 32; ++j) e += (L >= up[j]) ? 1 : 0;
        const int idx = L - up[e], m = mt[e];
        u.pm = bt[e] + idx % m; u.pn = e * npn + idx / m; return true;
    }
    __device__ __forceinline__ void a_ready(const Unit&) const {}
    __device__ __forceinline__ void done(const Unit&) const {}
};
}

struct Frame {
    LAS unsigned char* lds;
    volatile LAS int* MISC;
    int tid, lane, wave, G, bid;
    unsigned char* ws;
    const float* const* in;
    float* out;
};
#define WSP(type, off) ((type*)(F.ws + (off)))

struct TItem { const float* src; bf16* dst; int ldw; };
__device__ __forceinline__ TItem titem_decode(Frame& F, int it, int c4) {
    constexpr int I_A = 16 * 72, I_V = 16 * 16, I_O = 16 * 32, I_GU = 16 * 64, I_DN = 16 * 32;
    constexpr int PER_L = I_A + I_V + I_O + NE * I_GU + NE * I_DN;
    const int l = it / PER_L; int r = it % PER_L; TItem t;
    const float* win = F.in[I_WIN] + (size_t)l * D * INW;
    if (r < I_A) { const int k0 = (r / 72) * 64, n = (r % 72) * 32 + 4 * c4; const int sc = n < 1024 ? n : (n < 2048 ? n + 512 : n + 528);
        t.src = win + (size_t)k0 * INW + sc; t.dst = WSP(bf16, WS_WIN) + ((size_t)l * 2560 + (r % 72) * 32) * D + k0; t.ldw = INW; return t; } r -= I_A;
    if (r < I_V) { const int k0 = (r / 16) * 64, n0 = (r % 16) * 32; t.src = win + (size_t)k0 * INW + 1024 + n0 + 4 * c4; t.dst = WSP(bf16, WS_WV) + ((size_t)l * 512 + n0) * D + k0; t.ldw = INW; return t; } r -= I_V;
    if (r < I_O) { const int k0 = (r / 32) * 64, n0 = (r % 32) * 32; t.src = F.in[I_WOUT] + (size_t)l * D * D + (size_t)k0 * D + n0 + 4 * c4; t.dst = WSP(bf16, WS_WOUT) + ((size_t)l * D + n0) * D + k0; t.ldw = D; return t; } r -= I_O;
    if (r < NE * I_GU) { const int e = r / I_GU, q = r % I_GU, k0 = (q / 64) * 64, n0 = (q % 64) * 32, n = n0 + 4 * c4; const int d = (n >> 5) * 16 + (n & 15); const int sc = ((n >> 4) & 1) ? 1024 + d : d;
        t.src = F.in[I_WGU] + ((size_t)l * NE + e) * D * 2048 + (size_t)k0 * 2048 + sc; t.dst = WSP(bf16, WS_WGU) + (((size_t)l * NE + e) * 2048 + n0) * D + k0; t.ldw = 2048; return t; } r -= NE * I_GU;
    { const int e = r / I_DN, q = r % I_DN, k0 = (q / 32) * 64, n0 = (q % 32) * 32;
      t.src = F.in[I_WD] + ((size_t)l * NE + e) * D * D + (size_t)k0 * D + n0 + 4 * c4; t.dst = WSP(bf16, WS_WDN) + (((size_t)l * NE + e) * D + n0) * D + k0; t.ldw = D; return t; }
}
__device__ __forceinline__ void titem_load(const TItem& t, int lane, f32x4 (&v)[8]) {
#pragma unroll
    for (int q = 0; q < 8; ++q) v[q] = *(const f32x4*)(t.src + (size_t)(8 * (lane & 7) + q) * t.ldw);
}
__device__ __forceinline__ void titem_store(const TItem& t, const f32x4 (&v)[8], int lane) {
#pragma unroll
    for (int e = 0; e < 4; ++e) {
        v4u o; o.x = pk2(v[0][e], v[1][e]); o.y = pk2(v[2][e], v[3][e]); o.z = pk2(v[4][e], v[5][e]); o.w = pk2(v[6][e], v[7][e]);
        *(v4u*)(t.dst + (size_t)(4 * (lane >> 3) + e) * D + 8 * (lane & 7)) = o; }
}

__device__ __forceinline__ void p0_prologue(Frame& F) {
    const float* w_ada = F.in[I_WADA]; const float* b_ada = F.in[I_BADA]; const float* cvec = F.in[I_C]; const float* cctx = F.in[I_CCTX];
    {
        LAS float* red = (LAS float*)F.lds;
        for (int it = F.bid; it < 192; it += F.G) {
            const int l = it / 96, col = (it % 96) * 64 + F.lane;
            const float* W = w_ada + (size_t)l * D * 6144;
            float a0 = 0.f, a1 = 0.f;
            for (int k = F.wave * 128; k < F.wave * 128 + 128; ++k) {
                const float w = W[(size_t)k * 6144 + col]; const float c0 = cvec[k], c1 = cctx[k];
                a0 += (c0 * sigmoidf_(c0)) * w; a1 += (c1 * sigmoidf_(c1)) * w; }
            red[(F.wave * 2 + 0) * 64 + F.lane] = a0; red[(F.wave * 2 + 1) * 64 + F.lane] = a1;
            __syncthreads();
            if (F.wave < 2) { float s = 0.f;
#pragma unroll
                for (int w8 = 0; w8 < 8; ++w8) s += red[(w8 * 2 + F.wave) * 64 + F.lane];
                WSP(float, WS_MOD)[(size_t)(l * 2 + F.wave) * 6144 + col] = s + b_ada[(size_t)l * 6144 + col]; }
            __syncthreads();
        }
    }
    {
        const int gt = F.bid * 512 + F.tid, NT = F.G * 512;
        for (int i = gt; i < 256 * 16; i += NT) { const int pos = i >> 4, j = i & 15; const float inv = powf(10000.0f, -(float)(2 * j) / 32.0f);
            float s, c; sincosf((float)pos * inv, &s, &c); WSP(float, WS_ROPE)[2 * i] = c; WSP(float, WS_ROPE)[2 * i + 1] = s; }
        for (int i = gt; i < 64 * 64; i += NT) { float s, c; sincospif((float)(((i >> 6) * (i & 63)) & 63) / 32.0f, &s, &c); WSP(bf16, WS_FTAB)[i] = (bf16)f2bf(c); WSP(bf16, WS_FTAB)[4096 + i] = (bf16)f2bf(s); }
        for (int i = gt; i < 128 * 128; i += NT) { float s, c; sincospif((float)(((i >> 7) * (i & 127)) & 127) / 64.0f, &s, &c); WSP(bf16, WS_FTAB)[8192 + i] = (bf16)f2bf(c); WSP(bf16, WS_FTAB)[8192 + 16384 + i] = (bf16)f2bf(s); }
        for (int i = gt; i < 512; i += NT) WSP(unsigned, WS_F)[(size_t)T * 512 + i] = 0u;
        for (int i = gt; i < 2 * 16 * 1024; i += NT) { const int l = i >> 14, g = (i >> 10) & 15, k = i & 1023; WSP(float, WS_WGT)[i] = F.in[I_WIN][((size_t)l * D + k) * INW + 2560 + g]; }
        for (int i = gt; i < 2 * 32 * 1024; i += NT) { const int l = i >> 15, e = (i >> 10) & 31, k = i & 1023; WSP(float, WS_WRT)[i] = F.in[I_WR][((size_t)l * D + k) * NE + e]; }
    }
    {
        const int gw = F.bid * 8 + F.wave, NGW = F.G * 8;
        constexpr int PER_L = 16 * 72 + 16 * 16 + 16 * 32 + NE * (16 * 64) + NE * (16 * 32);
#pragma unroll 1
        for (int it = gw; it < 2 * PER_L; it += 4 * NGW) {
            const bool h1 = it + NGW < 2 * PER_L, h2 = it + 2 * NGW < 2 * PER_L, h3 = it + 3 * NGW < 2 * PER_L;
            const TItem ta = titem_decode(F, it, F.lane >> 3), tb = titem_decode(F, h1 ? it + NGW : it, F.lane >> 3), tc = titem_decode(F, h2 ? it + 2 * NGW : it, F.lane >> 3), td = titem_decode(F, h3 ? it + 3 * NGW : it, F.lane >> 3);
            f32x4 va[8], vb[8], vc[8], vd[8];
            titem_load(ta, F.lane, va); titem_load(tb, F.lane, vb); titem_load(tc, F.lane, vc); titem_load(td, F.lane, vd);
            titem_store(ta, va, F.lane); if (h1) titem_store(tb, vb, F.lane); if (h2) titem_store(tc, vc, F.lane); if (h3) titem_store(td, vd, F.lane);
        }
    }
}

template <int SRC, bool LAST>
__device__ __forceinline__ void row_phase(Frame& F, int l, const bool dry = false) {
    constexpr int ND = (SRC == 1) ? 32 : 16;
    const int lw = (SRC == 2) ? l + 1 : l;
    LAS float* wl = (LAS float*)F.lds;
    if (!LAST) {
        const float* wsrc = (SRC == 1) ? WSP(float, WS_WRT) + (size_t)l * 32 * D : WSP(float, WS_WGT) + (size_t)lw * 16 * D;
        for (int i = F.tid; i < ND * D / 4; i += 512) ((LAS f32x4*)wl)[i] = ((const f32x4*)wsrc)[i];
    }
    __syncthreads();
    const int row_lo = (l == 1 && SRC != 0) ? NCTX : 0;
    const int gw = F.bid * 8 + F.wave, NGW = F.G * 8;
    float* X = WSP(float, WS_X); float* Xo = dry ? WSP(float, WS_XG) : X; const int cl = dry ? l + 2 : l;
    float* gates_o = dry ? WSP(float, WS_YB) : WSP(float, WS_GATES); float* tokg_o = dry ? WSP(float, WS_YB + (2u << 20)) : WSP(float, WS_TOKG); int* elist_o = dry ? WSP(int, WS_YB + (4u << 20)) : WSP(int, WS_ELIST);
    if (SRC == 1) { if (F.tid < 32) F.MISC[256 + F.tid] = 0; __syncthreads(); }
    int it = -1;
    f32x4 pxa[4], pfa[4], pxb[4], pfb[4];
    v2u pya[16], pyb[16]; int tsn[4] = {0, 0, 0, 0};
#define ROW_LOAD(rr, px, pf, py) do { const int r_ = (rr); if (SRC == 0) { const f32x4* s_ = (const f32x4*)(r_ < NCTX ? F.in[I_CTX] + (size_t)r_ * D : F.in[I_X] + (size_t)(r_ - NCTX) * D); \
            _Pragma("unroll") for (int j_ = 0; j_ < 4; ++j_) px[j_] = s_[F.lane + 64 * j_]; } \
        else if (SRC == 1) { const f32x4* x_ = (const f32x4*)(l == 0 ? (r_ < NCTX ? F.in[I_CTX] + (size_t)r_ * D : F.in[I_X] + (size_t)(r_ - NCTX) * D) : X + (size_t)r_ * D); const v2u* m_ = (const v2u*)(WSP(bf16, WS_MIX) + (size_t)r_ * D); \
            _Pragma("unroll") for (int j_ = 0; j_ < 4; ++j_) { px[j_] = x_[F.lane + 64 * j_]; py[j_] = m_[F.lane + 64 * j_]; } } \
        else { const f32x4* x_ = (const f32x4*)(X + (size_t)r_ * D); \
            _Pragma("unroll") for (int j_ = 0; j_ < 4; ++j_) px[j_] = x_[F.lane + 64 * j_]; \
            _Pragma("unroll") for (int k_ = 0; k_ < 4; ++k_) _Pragma("unroll") for (int j_ = 0; j_ < 4; ++j_) py[k_ * 4 + j_] = ((const v2u*)(WSP(bf16, WS_YB) + (size_t)tsn[k_] * D))[F.lane + 64 * j_]; \
            if (r_ + NGW < T) { _Pragma("unroll") for (int k_ = 0; k_ < 4; ++k_) tsn[k_] = WSP(int, WS_TSLOT)[(size_t)(r_ + NGW) * 4 + k_]; } } } while (0)
    if (SRC == 2 && row_lo + gw < T) {
#pragma unroll
        for (int k = 0; k < 4; ++k) tsn[k] = WSP(int, WS_TSLOT)[(size_t)(row_lo + gw) * 4 + k]; }
    if (row_lo + gw < T) ROW_LOAD(row_lo + gw, pxa, pfa, pya);
    if (row_lo + gw + NGW < T) ROW_LOAD(row_lo + gw + NGW, pxb, pfb, pyb);
    auto body = [&](const int r, f32x4 (&px)[4], f32x4 (&pf)[4], v2u (&py)[16]) __attribute__((always_inline)) {
        ++it;
        const bool isctx = r < NCTX;
        const float* modv = WSP(float, WS_MOD) + (size_t)(l * 2 + (isctx ? 1 : 0)) * 6144;
        f32x4 v[4], cx[4], cf[4];
#pragma unroll
        for (int j = 0; j < 4; ++j) { cx[j] = px[j];
            if (SRC == 2) { f32x4 f_ = {0.f, 0.f, 0.f, 0.f};
#pragma unroll
                for (int k = 0; k < 4; ++k) { const v2u y_ = py[k * 4 + j]; f_[0] += bf_lo(y_.x); f_[1] += bf_hi(y_.x); f_[2] += bf_lo(y_.y); f_[3] += bf_hi(y_.y); }
                cf[j] = f_; } else if (SRC == 1) { const v2u y_ = py[j]; cf[j] = (f32x4){bf_lo(y_.x), bf_hi(y_.x), bf_lo(y_.y), bf_hi(y_.y)}; } else cf[j] = pf[j]; }
        if (r + 2 * NGW < T) ROW_LOAD(r + 2 * NGW, px, pf, py);
        if (SRC == 0) {
#pragma unroll
            for (int j = 0; j < 4; ++j) v[j] = cx[j];
        } else {
            const f32x4* gp = (const f32x4*)(modv + (SRC == 1 ? 2048 : 5120));
            f32x4 t[4]; float s = 0.f;
#pragma unroll
            for (int j = 0; j < 4; ++j) {
                f32x4 f;
                f = cf[j];
                t[j] = cx[j] * DN_ALPHA + gp[F.lane + 64 * j] * f;
                s += (t[j][0] + t[j][1]) + (t[j][2] + t[j][3]);
            }
            const float mean = wave_sum_u(s) * (1.f / D); float s2 = 0.f;
#pragma unroll
            for (int j = 0; j < 4; ++j) { t[j] = t[j] - mean; s2 += (t[j][0] * t[j][0] + t[j][1] * t[j][1]) + (t[j][2] * t[j][2] + t[j][3] * t[j][3]); }
            const float rstd = rsqrtf(wave_sum_u(s2) * (1.f / D) + LN_EPS);
            const f32x4* lw4 = (const f32x4*)(F.in[SRC == 1 ? I_LN1W : I_LN2W] + (size_t)l * D);
            const f32x4* lb4 = (const f32x4*)(F.in[SRC == 1 ? I_LN1B : I_LN2B] + (size_t)l * D);
#pragma unroll
            for (int j = 0; j < 4; ++j) v[j] = t[j] * rstd * lw4[F.lane + 64 * j] + lb4[F.lane + 64 * j];
        }
        if (LAST) {
            f32x4* o = (f32x4*)(F.out + (size_t)(r - NCTX) * D);
#pragma unroll
            for (int j = 0; j < 4; ++j) o[F.lane + 64 * j] = v[j];
            return;
        }
        if (SRC != 0) {
            f32x4* o = (f32x4*)(Xo + (size_t)r * D);
#pragma unroll
            for (int j = 0; j < 4; ++j) o[F.lane + 64 * j] = v[j];
        }
        const float* modn = (SRC == 2) ? WSP(float, WS_MOD) + (size_t)(lw * 2 + (isctx ? 1 : 0)) * 6144 : modv;
        const f32x4* shp = (const f32x4*)(modn + (SRC == 1 ? 3072 : 0));
        const f32x4* scp = (const f32x4*)(modn + (SRC == 1 ? 4096 : 1024));
        bf16* hdst = (dry ? WSP(bf16, WS_ACT) : (SRC == 1 ? WSP(bf16, WS_F) : WSP(bf16, WS_H))) + (size_t)r * D;
        f32x4 h[4];
#pragma unroll
        for (int j = 0; j < 4; ++j) { h[j] = v[j] * (scp[F.lane + 64 * j] + 1.0f) + shp[F.lane + 64 * j];
            v2u w; w.x = pk2(h[j][0], h[j][1]); w.y = pk2(h[j][2], h[j][3]); ((v2u*)hdst)[F.lane + 64 * j] = w; }
        float pv[ND];
#pragma unroll
        for (int o = 0; o < ND; ++o) {
            f32x2 p2 = {0.f, 0.f};
#pragma unroll
            for (int j = 0; j < 4; ++j) { const f32x4 w = ((const LAS f32x4*)(wl + o * D))[F.lane + 64 * j];
                p2 = __builtin_elementwise_fma((f32x2){h[j][0], h[j][1]}, (f32x2){w[0], w[1]}, p2); p2 = __builtin_elementwise_fma((f32x2){h[j][2], h[j][3]}, (f32x2){w[2], w[3]}, p2); }
            pv[o] = p2[0] + p2[1];
            if ((o & 3) == 3) asm volatile("" ::: "memory");
        }
#define RS_SW32(n_) do { _Pragma("unroll") for (int i_ = 0; i_ < (n_); ++i_) { SWAP32(pv[i_], pv[i_ + (n_)]); pv[i_] += pv[i_ + (n_)]; } } while (0)
#define RS_SW16(n_) do { _Pragma("unroll") for (int i_ = 0; i_ < (n_); ++i_) { SWAP16(pv[i_], pv[i_ + (n_)]); pv[i_] += pv[i_ + (n_)]; } } while (0)
#define RS_SEL(n_, bit_) const bool up_ = (F.lane & (bit_)) != 0; const float snd_ = up_ ? pv[i_] : pv[i_ + (n_)], keep_ = up_ ? pv[i_ + (n_)] : pv[i_]
#define RS_D8(n_) do { _Pragma("unroll") for (int i_ = 0; i_ < (n_); ++i_) { RS_SEL(n_, 8); pv[i_] = keep_ + dpp0<0x128, 0xf, 0xf>(snd_); } } while (0)
#define RS_D4(n_) do { _Pragma("unroll") for (int i_ = 0; i_ < (n_); ++i_) { RS_SEL(n_, 4); pv[i_] = keep_ + dppo<0x114, 0xf, 0xa>(dpp0<0x104, 0xf, 0x5>(snd_), snd_); } } while (0)
#define RS_D2(n_) do { _Pragma("unroll") for (int i_ = 0; i_ < (n_); ++i_) { RS_SEL(n_, 2); pv[i_] = keep_ + dpp0<0x4E, 0xf, 0xf>(snd_); } } while (0)
        if constexpr (ND == 32) { RS_SW32(16); RS_SW16(8); RS_D8(4); RS_D4(2); RS_D2(1); pv[0] += dpp0<0xB1, 0xf, 0xf>(pv[0]); }
        else { RS_SW32(8); RS_SW16(4); RS_D8(2); RS_D4(1); pv[0] += dpp0<0x4E, 0xf, 0xf>(pv[0]); pv[0] += dpp0<0xB1, 0xf, 0xf>(pv[0]); }
#undef RS_SW32
#undef RS_SW16
#undef RS_SEL
#undef RS_D8
#undef RS_D4
#undef RS_D2
        const float mine = pv[0];
        if (SRC != 1) {
            if ((F.lane & 3) == 0) gates_o[(size_t)r * 16 + (F.lane >> 2)] = mine + F.in[I_GBIAS][lw * 16 + (F.lane >> 2)];
        } else {
            float val = ((F.lane & 1) == 0) ? mine + F.in[I_BR][l * 32 + (F.lane >> 1)] : -INFINITY;
            float tv[4]; int ti[4];
            int cnt = 0;
#pragma unroll
            for (int e = 0; e < 32; ++e) { const float se = __builtin_bit_cast(float, __builtin_amdgcn_readlane(__builtin_bit_cast(int, val), 2 * e)); cnt += (se > val) ? 1 : 0; }
            const bool evl = (F.lane & 1) == 0;
            const unsigned long long b0 = __builtin_amdgcn_ballot_w64(evl && cnt == 0), b1 = __builtin_amdgcn_ballot_w64(evl && cnt == 1), b2 = __builtin_amdgcn_ballot_w64(evl && cnt == 2), b3 = __builtin_amdgcn_ballot_w64(evl && cnt == 3);
            if (__builtin_popcountll(b0) == 1 && __builtin_popcountll(b1) == 1 && __builtin_popcountll(b2) == 1 && __builtin_popcountll(b3) == 1) {
                const int l0 = __builtin_ctzll(b0), l1 = __builtin_ctzll(b1), l2 = __builtin_ctzll(b2), l3 = __builtin_ctzll(b3);
                ti[0] = l0 >> 1; ti[1] = l1 >> 1; ti[2] = l2 >> 1; ti[3] = l3 >> 1;
                tv[0] = __builtin_bit_cast(float, __builtin_amdgcn_readlane(__builtin_bit_cast(int, val), l0)); tv[1] = __builtin_bit_cast(float, __builtin_amdgcn_readlane(__builtin_bit_cast(int, val), l1));
                tv[2] = __builtin_bit_cast(float, __builtin_amdgcn_readlane(__builtin_bit_cast(int, val), l2)); tv[3] = __builtin_bit_cast(float, __builtin_amdgcn_readlane(__builtin_bit_cast(int, val), l3));
            } else {
#pragma unroll 1
            for (int k = 0; k < 4; ++k) {
                float bv = val; int bi = F.lane >> 1;
#pragma unroll
                for (int off = 32; off >= 1; off >>= 1) { const float ov = shx(bv, F.lane, off); const int oi = shxi(bi, F.lane, off); if (ov > bv || (ov == bv && oi < bi)) { bv = ov; bi = oi; } }
                if (k == 0) { tv[0] = bv; ti[0] = bi; } else if (k == 1) { tv[1] = bv; ti[1] = bi; } else if (k == 2) { tv[2] = bv; ti[2] = bi; } else { tv[3] = bv; ti[3] = bi; }
                if ((F.lane >> 1) == bi) val = -INFINITY;
            }
            }
            const float e1 = __expf(tv[1] - tv[0]), e2 = __expf(tv[2] - tv[0]), e3 = __expf(tv[3] - tv[0]);
            const float inv = 1.0f / (1.0f + e1 + e2 + e3);
            if (F.lane < 4) {
                const int e = F.lane == 0 ? ti[0] : F.lane == 1 ? ti[1] : F.lane == 2 ? ti[2] : ti[3];
                const float g = (F.lane == 0 ? 1.0f : F.lane == 1 ? e1 : F.lane == 2 ? e2 : e3) * inv;
                const int lrank = __hip_atomic_fetch_add((LAS int*)(F.MISC + 256 + e), 1, __ATOMIC_RELAXED, __HIP_MEMORY_SCOPE_WORKGROUP);
                F.MISC[320 + (F.wave * 9 + it) * 4 + F.lane] = (e << 16) | lrank;
                tokg_o[(size_t)r * 4 + F.lane] = g;
            }
        }
    };
#pragma unroll 1
    for (int r = row_lo + gw; r < T; r += 2 * NGW) {
        body(r, pxa, pfa, pya);
        if (r + NGW < T) body(r + NGW, pxb, pfb, pyb);
    }
    __syncthreads();
    if (SRC == 1) {
        if (F.tid < 32) { const int c = F.MISC[256 + F.tid];
            F.MISC[288 + F.tid] = c > 0 ? (int)__hip_atomic_fetch_add(WSP(unsigned, WS_CTL) + CW_CNT + (cl * 32 + F.tid) * 64, (unsigned)c, RLX_AGENT) : 0; }
        __syncthreads();
        int it2 = 0;
        for (int r = row_lo + gw; r < T; r += NGW, ++it2) {
            if (F.lane < 4) { const int pk = F.MISC[320 + (F.wave * 9 + it2) * 4 + F.lane]; const int e = pk >> 16, lr = pk & 0xffff;
                elist_o[(size_t)e * T + F.MISC[288 + e] + lr] = r * 4 + F.lane; }
        }
        __syncthreads();
    }
}

__device__ __forceinline__ void moe_prefix(Frame& F, int l, int npn) {
    if (F.tid == 0) {
        int u = 0, b = 0;
        for (int e = 0; e < NE; ++e) { const int c = (int)__hip_atomic_load(WSP(unsigned, WS_CTL) + CW_CNT + (l * 32 + e) * 64, RLX_AGENT); const int m = (c + 255) >> 8;
            F.MISC[e] = u; F.MISC[64 + e] = m; F.MISC[128 + e] = b; u += m * npn; b += m; }
        F.MISC[32] = u; F.MISC[128 + 32] = b;
    }
    __syncthreads();
}
__device__ __forceinline__ void moe_gather(Frame& F, int l) {
    moe_prefix(F, l, 1);
    const int total_rows = F.MISC[128 + 32] * 256;
    for (int g = F.bid * 512 + F.tid; g < total_rows; g += F.G * 512) {
        const int tile = g >> 8; int e = 0;
#pragma unroll 1
        for (int j = 1; j < 32; ++j) e += (tile >= F.MISC[128 + j]) ? 1 : 0;
        const int s = (tile - F.MISC[128 + e]) * 256 + (g & 255);
        const int cnt = (int)__hip_atomic_load(WSP(unsigned, WS_CTL) + CW_CNT + (l * 32 + e) * 64, RLX_AGENT);
        int asg = -1; if (s < cnt) asg = WSP(int, WS_ELIST)[(size_t)e * T + s];
        WSP(int, WS_SROW)[g] = asg >= 0 ? (asg >> 2) : T;
        WSP(float, WS_SG)[g] = asg >= 0 ? WSP(float, WS_TOKG)[asg] : 0.f;
        if (asg >= 0) WSP(int, WS_TSLOT)[asg] = g;
    }
}

constexpr int ATT_KS = 8192, ATT_VOFF = 24576, ATT_QOFF = 73728;
#define ATT_THR 8.0f
#define ATT_GLDS(src, dst) __builtin_amdgcn_global_load_lds((const unsigned*)(src), (LAS unsigned*)(dst), 16, 0, 0)
#define ATT_MFMA(a, b, c) __builtin_amdgcn_mfma_f32_32x32x16_bf16((a), (b), (c), 0, 0, 0)
typedef int v8i __attribute__((ext_vector_type(8)));
#define ATT_MFMA8X(a, b, c) __builtin_amdgcn_mfma_scale_f32_32x32x64_f8f6f4((a), (b), (c), 0, 0, 0, 0x7F7F7F7F, 0, 0x7F7F7F7F)
#define ATT_CAT8(lo, hi) __builtin_bit_cast(v8i, __builtin_shufflevector((lo), (hi), 0, 1, 2, 3, 4, 5, 6, 7))
#define ATT_ZERO16 ((f32x16){0.f, 0.f, 0.f, 0.f, 0.f, 0.f, 0.f, 0.f, 0.f, 0.f, 0.f, 0.f, 0.f, 0.f, 0.f, 0.f})
__device__ __forceinline__ void attn_qk0(const LAS unsigned char* kb, const v8i qf, int q, int hh, f32x16& S0, f32x16& S1) {
    const int pq = (q & ~12) | ((q & 4) << 1) | ((q & 8) >> 1);
    const int swk = (pq >> 2) & 3;
    const v4u a0l = *(const LAS v4u*)(kb + pq * 64 + (((2 * hh) ^ swk) * 16)), a0h = *(const LAS v4u*)(kb + pq * 64 + (((2 * hh + 1) ^ swk) * 16));
    const v4u a1l = *(const LAS v4u*)(kb + (32 + pq) * 64 + (((2 * hh) ^ swk) * 16)), a1h = *(const LAS v4u*)(kb + (32 + pq) * 64 + (((2 * hh + 1) ^ swk) * 16));
    S0 = ATT_MFMA8X(ATT_CAT8(a0l, a0h), qf, ATT_ZERO16); S1 = ATT_MFMA8X(ATT_CAT8(a1l, a1h), qf, ATT_ZERO16);
}
__device__ __forceinline__ void attn_pv(const LAS unsigned char* vb, const bf16x8 (&pf)[2][2], f32x16 (&O)[4], int q, int hh) {
    const int sw = (q >> 1) & 7;
#pragma unroll
    for (int d = 0; d < 4; ++d) { const LAS unsigned char* vrow = vb + (d * 32 + q) * 128;
#pragma unroll
        for (int f = 0; f < 4; ++f) { const int c16 = 2 * f + hh;
            O[d] = ATT_MFMA(*(const LAS bf16x8*)(vrow + ((c16 ^ sw) * 16)), pf[f >> 1][f & 1], O[d]); } }
}
#ifndef ATT_PF
#define ATT_PF 2
#endif
constexpr int att_use(bool ZERO, int f) { return f < 16 ? f : (ZERO ? 16 : 17) + ((f - 16) >> 1); }
constexpr int att_nw(bool ZERO, int g) { int n = 0; for (int f = 0; f < 20; ++f) { const int u = att_use(ZERO, f); if (u > g && u <= g + ATT_PF) ++n; } return n; }
template <class DMA>
__device__ __forceinline__ void attn_iter(const DMA& dma  , const bool dsel, const bool ZERO  , const bool FAST  , const LAS unsigned char* vb, const LAS unsigned char* kb, const v8i qf, f32x16& Sc0, f32x16& Sc1, f32x16& Sn0, f32x16& Sn1,
                                          bf16x8 (&pfp)[2][2], bf16x8 (&pfc)[2][2], f32x16 (&O)[4], float& m, float& lsum, bf16x8& bneg, const bool first, int q, int hh) {
    if (!ZERO && !FAST) {
    float mx = Sc0[0];
#pragma unroll
    for (int i = 1; i < 16; ++i) mx = fmaxf(mx, Sc0[i]);
#pragma unroll
    for (int i = 0; i < 16; ++i) mx = fmaxf(mx, Sc1[i]);
    mx = fmaxf(mx, shx(mx, q + 32 * hh, 32));
    if (first || !__all(mx <= ATT_THR)) {
        const float mnew = bf_lo(f2bf(m + (first ? mx : fmaxf(mx, 0.f)))); const float dm = mnew - m; const float alpha = first ? 0.f : __builtin_amdgcn_exp2f(-dm); m = mnew; lsum *= alpha;
        { v4u bn = {0u, 0u, 0u, 0u}; if (hh == 0) bn.x = f2bf(-m); bneg = __builtin_bit_cast(bf16x8, bn); }
#pragma unroll
        for (int i = 0; i < 16; ++i) { Sc0[i] -= dm; Sc1[i] -= dm; }
#pragma unroll
        for (int d = 0; d < 4; ++d)
#pragma unroll
            for (int i = 0; i < 16; ++i) O[d][i] *= alpha;
#pragma unroll
        for (int a = 0; a < 2; ++a)
#pragma unroll
            for (int b2 = 0; b2 < 2; ++b2) { v4u w = __builtin_bit_cast(v4u, pfp[a][b2]);
                w.x = pk2(bf_lo(w.x) * alpha, bf_hi(w.x) * alpha); w.y = pk2(bf_lo(w.y) * alpha, bf_hi(w.y) * alpha); w.z = pk2(bf_lo(w.z) * alpha, bf_hi(w.z) * alpha); w.w = pk2(bf_lo(w.w) * alpha, bf_hi(w.w) * alpha);
                pfp[a][b2] = __builtin_bit_cast(bf16x8, w); }
    }
    }
    __builtin_amdgcn_sched_barrier(0);
    const int sw = (q >> 1) & 7;
    float ps = 0.f; unsigned pw[16];
    bf16x8 fa[16]; v4u fk[4];
    const int pq = (q & ~12) | ((q & 4) << 1) | ((q & 8) >> 1), swk = (pq >> 2) & 3;
    unsigned vad[4], kad[2];
#pragma unroll
    for (int i = 0; i < 4; ++i) vad[i] = (unsigned)(size_t)(vb + q * 128 + (((2 * i + hh) ^ sw) * 16));
#pragma unroll
    for (int i = 0; i < 2; ++i) kad[i] = (unsigned)(size_t)(kb + pq * 64 + (((2 * hh + i) ^ swk) * 16));
#define ATT_LDFRAG(f) do { if ((f) < 16) asm volatile("ds_read_b128 %0, %1 offset:%2" : "=v"(fa[(f)]) : "v"(vad[(f) & 3]), "n"(((f) >> 2) * 4096)); \
        else asm volatile("ds_read_b128 %0, %1 offset:%2" : "=v"(fk[(f) - 16]) : "v"(kad[((f) - 16) & 1]), "n"((((f) - 16) >> 1) * 2048)); } while (0)
#ifndef ATT_PF
#define ATT_PF 2
#endif
#ifndef ATT_D0
#define ATT_D0 0
#endif
#ifndef ATT_D1
#define ATT_D1 8
#endif
    const int QK0 = ZERO ? 16 : 17, NS = QK0 + 2;
#define ATT_USE(f) ((f) < 16 ? (f) : QK0 + (((f) - 16) >> 1))
#pragma unroll
    for (int f = 0; f < 20; ++f) if (ATT_USE(f) - ATT_PF < 0) ATT_LDFRAG(f);
#pragma unroll
    for (int g = 0; g < NS; ++g) {
#pragma unroll
        for (int f = 0; f < 20; ++f) if (ATT_USE(f) - ATT_PF == g) ATT_LDFRAG(f);
        if (g == ATT_D0) { if (!dsel) dma(); }
        if (g == ATT_D1) { if (dsel) dma(); }
        if (g < 16) { asm volatile("s_waitcnt lgkmcnt(%1)" : "+v"(fa[g]) : "n"(att_nw(ZERO, g))); O[g >> 2] = ATT_MFMA(fa[g], pfp[(g & 3) >> 1][g & 1], O[g >> 2]); }
        else if (g < QK0) { v4u a1_ = {0u, 0u, 0u, 0u}; if (hh == 0) a1_.x = 0x3F80u; asm volatile("" : "+v"(a1_));
            Sn1 = ATT_MFMA(__builtin_bit_cast(bf16x8, a1_), bneg, ATT_ZERO16); }
        else if (g == QK0) { asm volatile("s_waitcnt lgkmcnt(%2)" : "+v"(fk[0]), "+v"(fk[1]) : "n"(att_nw(ZERO, g)));
            if (ZERO) Sn0 = ATT_MFMA8X(ATT_CAT8(fk[0], fk[1]), qf, ATT_ZERO16); else Sn0 = ATT_MFMA8X(ATT_CAT8(fk[0], fk[1]), qf, Sn1); }
        else { asm volatile("s_waitcnt lgkmcnt(%2)" : "+v"(fk[2]), "+v"(fk[3]) : "n"(att_nw(ZERO, g)));
            if (ZERO) Sn1 = ATT_MFMA8X(ATT_CAT8(fk[2], fk[3]), qf, ATT_ZERO16); else Sn1 = ATT_MFMA8X(ATT_CAT8(fk[2], fk[3]), qf, Sn1); }
        if (g < 16) {
#pragma unroll
            for (int e = 2 * g; e < 2 * g + 2; ++e) { float pe = __builtin_amdgcn_exp2f(e < 16 ? Sc0[e & 15] : Sc1[e & 15]); asm volatile("" : "+v"(pe)); ps += pe; if (e < 16) Sc0[e & 15] = pe; else Sc1[e & 15] = pe; }
        } else {
#pragma unroll
            for (int w = (16 * (g - 16)) / (NS - 16); w < (16 * (g - 15)) / (NS - 16); ++w) { pw[w] = (w < 8) ? pk2(Sc0[2 * w], Sc0[2 * w + 1]) : pk2(Sc1[2 * w - 16], Sc1[2 * w - 15]); }
        }
        __builtin_amdgcn_sched_barrier(0);
    }
#undef ATT_USE
#undef ATT_LDFRAG
    lsum += ps;
#pragma unroll
    for (int blk = 0; blk < 2; ++blk)
#pragma unroll
        for (int s2 = 0; s2 < 2; ++s2) pfc[blk][s2] = __builtin_bit_cast(bf16x8, (v4u){pw[8 * blk + 4 * s2 + 0], pw[8 * blk + 4 * s2 + 1], pw[8 * blk + 4 * s2 + 2], pw[8 * blk + 4 * s2 + 3]});
}
template <int VAR>
__device__ __forceinline__ void attn_unit(Frame& F, int l, int head, int qt, int nkt, float lam, float oml) {
    const int wave = F.wave, lane = F.lane;
    const int map = wave >> 2, q = lane & 31, hh = lane >> 5;
    const bf16* Q = WSP(bf16, WS_QB); const bf16* K = WSP(bf16, WS_KB); const bf16* VT = WSP(bf16, WS_VT);
    const int qrow = qt * 128 + (wave & 3) * 32 + q;
    float qn1 = 0.f;
    const unsigned char* Q8 = (const unsigned char*)Q; const unsigned char* K8 = (const unsigned char*)K;
    v8i qf;
    { const v4u q0 = *(const v4u*)(Q8 + ((size_t)(head * 2 + map) * T + qrow) * 64 + hh * 32), q1 = *(const v4u*)(Q8 + ((size_t)(head * 2 + map) * T + qrow) * 64 + hh * 32 + 16);
      qf = ATT_CAT8(q0, q1);
#define ATT_Q8SQ(w_, b_) { const float x_ = __builtin_amdgcn_cvt_f32_fp8((int)(w_), b_); qn1 += x_ * x_; }
#define ATT_Q8SQ4(w_) ATT_Q8SQ(w_, 0) ATT_Q8SQ(w_, 1) ATT_Q8SQ(w_, 2) ATT_Q8SQ(w_, 3)
      ATT_Q8SQ4(q0.x) ATT_Q8SQ4(q0.y) ATT_Q8SQ4(q0.z) ATT_Q8SQ4(q0.w) ATT_Q8SQ4(q1.x) ATT_Q8SQ4(q1.y) ATT_Q8SQ4(q1.z) ATT_Q8SQ4(q1.w)
#undef ATT_Q8SQ4
#undef ATT_Q8SQ
    }
    qn1 += shx(qn1, lane, 32);
    const unsigned* kq = WSP(unsigned, WS_CTL) + CW_KINF + l * 16 + (head * 2 + map) * 2;
    const float sbound = sqrtf(qn1 * (__uint_as_float(__hip_atomic_load(kq, RLX_AGENT)) + __uint_as_float(__hip_atomic_load(kq + 1, RLX_AGENT)))) * 1.08f;
    { LAS v4u* z = (LAS v4u*)(F.lds + ATT_VOFF + 2 * 16384); z[F.tid] = (v4u){0u, 0u, 0u, 0u}; z[F.tid + 512] = (v4u){0u, 0u, 0u, 0u}; }
    f32x16 O[4];
#pragma unroll
    for (int d = 0; d < 4; ++d)
#pragma unroll
        for (int i = 0; i < 16; ++i) O[d][i] = 0.f;
    float m = 0.f, lsum = 0.f;
    bf16x8 bneg = (bf16x8){0, 0, 0, 0, 0, 0, 0, 0};
    const char* const sK1 = (const char*)(K8 + ((size_t)(head * 2 + (wave >> 2)) * T + (wave & 3) * 16) * 64);
    const char* const sV0 = (const char*)(VT + (size_t)(head * 128 + wave * 16) * T);
    const char* const sV1 = (const char*)(VT + (size_t)(head * 128 + wave * 16 + 8) * T);
    const int r8 = lane >> 3, c8 = lane & 7; const unsigned oK = (unsigned)((lane >> 2) * 64 + (((lane & 3) ^ ((lane >> 4) & 3)) * 16));
    const unsigned oV0 = (unsigned)(r8 * T + ((c8 ^ (r8 >> 1)) * 8)) * 2u, oV1 = oV0 ^ 64u;
#define ATT_OFFS() do {} while (0)
    LAS unsigned char* const wb = F.lds + wave * 1024;
#define ATT_LOADK(t, slot) do { const int kt_ = (t) < nkt ? (t) : nkt - 1; LAS unsigned char* b_ = wb + (slot) * ATT_KS; \
        ATT_GLDS(sK1 + (size_t)kt_ * 4096 + oK, b_); } while (0)
#define ATT_LOADV(t, slot) do { const int kt_ = (t) < nkt ? (t) : nkt - 1; LAS unsigned char* b_ = wb + ATT_VOFF + (slot) * 16384 + wave * 1024; \
        ATT_GLDS(sV0 + (size_t)kt_ * 128 + oV0, b_); ATT_GLDS(sV1 + (size_t)kt_ * 128 + oV1, b_ + 1024); } while (0)
#define ATT_SYNC(n) do { asm volatile("s_waitcnt vmcnt(" #n ")" ::: "memory"); __builtin_amdgcn_s_barrier(); asm volatile("" ::: "memory"); } while (0)
    f32x16 Sa0, Sa1, Sb0, Sb1; bf16x8 pfa[2][2], pfb[2][2];
#pragma unroll
    for (int i = 0; i < 2; ++i)
#pragma unroll
        for (int j = 0; j < 2; ++j) { pfa[i][j] = (bf16x8){0, 0, 0, 0, 0, 0, 0, 0}; pfb[i][j] = pfa[i][j]; }
    const LAS unsigned char* const kmap = F.lds + map * 4096; const LAS unsigned char* const vbase = F.lds + ATT_VOFF;
    ATT_LOADK(0, 0); ATT_LOADK(1, 1);
    ATT_SYNC(1);
    attn_qk0(kmap, qf, q, hh, Sa0, Sa1);
    ATT_LOADK(2, 2); ATT_LOADV(0, 0);
    int s0 = 0;
#define ATT_PAIR(ZEROV, FASTV, jj) do { const int j = (jj); const int s1 = s0 == 2 ? 0 : s0 + 1, s2 = s1 == 2 ? 0 : s1 + 1;    \
        ATT_SYNC(3);                                                        \
        { auto dma_ = [&]() { if (VAR != 1) { ATT_LOADK(j + 3, s0); ATT_LOADV(j + 1, s1); } }; \
          if (VAR != 2) attn_iter(dma_, map != 0, ZEROV, FASTV, vbase + s2 * 16384, kmap + s1 * ATT_KS, qf, Sa0, Sa1, Sb0, Sb1, pfb, pfa, O, m, lsum, bneg, j == 0, q, hh); else dma_(); }        \
        ATT_SYNC(3); \
        { auto dma_ = [&]() { if (VAR != 1) { ATT_LOADK(j + 4, s1); ATT_LOADV(j + 2, s2); } }; \
          if (VAR != 2) attn_iter(dma_, map != 0, ZEROV, FASTV, vbase + s0 * 16384, kmap + s2 * ATT_KS, qf, Sb0, Sb1, Sa0, Sa1, pfa, pfb, O, m, lsum, bneg, false, q, hh); else dma_(); }        \
        s0 = s2; } while (0)
    if (__all(sbound <= 60.0f) != 0) {
#pragma unroll 1
        for (int jj = 0; jj < nkt; jj += 2) ATT_PAIR(true, true, jj);
    } else {
        bool fast = false;
#pragma unroll 1
        for (int jj = 0; jj < nkt; jj += 2) {
            ATT_PAIR(false, fast, jj);
            if (jj == 0) fast = __all(sbound - m <= 60.0f) != 0;
        }
    }
#undef ATT_PAIR
    ATT_SYNC(0);
    if (VAR != 2) attn_pv(vbase + (s0 == 0 ? 2 : s0 - 1) * 16384, pfb, O, q, hh);
    ATT_SYNC(0);
#undef ATT_LOADK
#undef ATT_LOADV
#undef ATT_SYNC
#undef ATT_OFFS
    int lnE = lane; asm volatile("" : "+v"(lnE));
    const int qE = lnE & 31, hhE = lnE >> 5;
    const float inv = 1.0f / (lsum + shx(lsum, lnE, 32));
#pragma unroll
    for (int d = 0; d < 4; ++d)
#pragma unroll
        for (int i = 0; i < 16; ++i) O[d][i] *= inv;
    LAS float* X2 = (LAS float*)F.lds;
    if (map == 1) {
#pragma unroll
        for (int d = 0; d < 4; ++d)
#pragma unroll
            for (int i = 0; i < 16; ++i) X2[((wave & 3) * 64 + d * 16 + i) * 64 + lnE] = O[d][i];
    }
    __syncthreads();
    LAS unsigned char* tile = F.lds + 65536 + (wave & 3) * 8704;
    if (map == 0) {
        float ss = 0.f;
#pragma unroll
        for (int d = 0; d < 4; ++d) {
            asm volatile("" ::: "memory");
#pragma unroll
            for (int i = 0; i < 16; ++i) { const float o = O[d][i] - lam * X2[((wave & 3) * 64 + d * 16 + i) * 64 + lnE]; O[d][i] = o; ss += o * o; } }
        ss += shx(ss, lnE, 32);
        const float r = rsqrtf(ss * (1.0f / 128.0f) + LN_EPS) * oml;
        const float* nw = F.in[I_DNW] + (size_t)l * 512 + head * 128;
#pragma unroll
        for (int d = 0; d < 4; ++d) {
            asm volatile("" ::: "memory");
#pragma unroll
            for (int i = 0; i < 16; i += 2) {
                const int dv = d * 32 + (i & 3) + 8 * (i >> 2) + 4 * hhE;
                *(LAS unsigned*)(tile + qE * 272 + dv * 2) = pk2(O[d][i] * r * nw[dv], O[d][i + 1] * r * nw[dv + 1]);
            } }
    }
    __syncthreads();
    if (map == 0) {
        bf16* dst = (VAR ? WSP(bf16, WS_XG) : WSP(bf16, WS_AOUT)) + (size_t)(qt * 128 + wave * 32) * D + head * 128;
#pragma unroll
        for (int c = 0; c < 8; ++c) { const int idx = lnE + 64 * c, row = idx >> 4, ch = idx & 15;
            *(v4u*)(dst + (size_t)row * D + ch * 8) = *(const LAS v4u*)(tile + row * 272 + ch * 16); }
    }
    __syncthreads();
}

constexpr int FT_C128 = 0, FT_S128 = 34816, FT_C64 = 69632, FT_S64 = 78848, FT_DATA = 88064;
__device__ __forceinline__ void fft_tables(Frame& F) {
    const bf16* tab = WSP(bf16, WS_FTAB);
    for (int i = F.tid; i < 2 * 64 * 8; i += 512) { const int m = i >> 9, r = (i >> 3) & 63, c = i & 7;
        *(LAS v4u*)(F.lds + (m ? FT_S64 : FT_C64) + r * 144 + c * 16) = *(const v4u*)(tab + m * 4096 + r * 64 + c * 8); }
    for (int i = F.tid; i < 2 * 128 * 16; i += 512) { const int m = i >> 11, r = (i >> 4) & 127, c = i & 15;
        *(LAS v4u*)(F.lds + (m ? FT_S128 : FT_C128) + r * 272 + c * 16) = *(const v4u*)(tab + 8192 + m * 16384 + r * 128 + c * 8); }
    __syncthreads();
}
__device__ __forceinline__ void fft_tab256(Frame& F) {
    LAS float* tab256 = (LAS float*)(F.lds + TAB_OFF);
    if (F.tid < 256) tab256[F.tid] = cospif((float)F.tid / 128.0f);
    __syncthreads();
}
__device__ __forceinline__ bf16x8 pack8(const f32x16& a, int s) {
    v4u w; w.x = pk2(a[8 * s + 0], a[8 * s + 1]); w.y = pk2(a[8 * s + 2], a[8 * s + 3]); w.z = pk2(a[8 * s + 4], a[8 * s + 5]); w.w = pk2(a[8 * s + 6], a[8 * s + 7]); return __builtin_bit_cast(bf16x8, w);
}
__device__ __forceinline__ void fft1_unit(Frame& F, int n2, int g) {
    const int tid = F.tid, wave = F.wave, lane = F.lane;
    const bf16* U = WSP(bf16, WS_MQ + 4 * SEGB);
    LAS unsigned char* ub = F.lds + FT_DATA;
#pragma unroll
    for (int i = 0; i < 2; ++i) { const int id = tid + 512 * i, r = id >> 3, c8 = id & 7;
        *(LAS v4u*)(ub + r * 144 + c8 * 16) = *(const v4u*)(U + (size_t)(NCTX + 128 * r + n2) * 256 + g * 64 + c8 * 8); }
    __syncthreads();
    const int rt = wave & 3, ct = wave >> 2, i = lane & 31, hh = lane >> 5;
    bf16x8 zP[4][2], zQ[4][2];
#pragma unroll
    for (int rr = 0; rr < 4; ++rr) {
        f32x16 aP, aQ;
#pragma unroll
        for (int j = 0; j < 16; ++j) { aP[j] = 0.f; aQ[j] = 0.f; }
#pragma unroll
        for (int s = 0; s < 4; ++s) {
            const bf16x8 a = *(const LAS bf16x8*)(ub + (rr * 32 + i) * 144 + (s * 16 + hh * 8) * 2);
            const bf16x8 bc = *(const LAS bf16x8*)(F.lds + FT_C64 + (ct * 32 + i) * 144 + (s * 16 + hh * 8) * 2), bs = *(const LAS bf16x8*)(F.lds + FT_S64 + (ct * 32 + i) * 144 + (s * 16 + hh * 8) * 2);
            aP = __builtin_amdgcn_mfma_f32_32x32x16_bf16(a, bc, aP, 0, 0, 0); aQ = __builtin_amdgcn_mfma_f32_32x32x16_bf16(a, bs, aQ, 0, 0, 0);
        }
        zP[rr][0] = pack8(aP, 0); zP[rr][1] = pack8(aP, 1); zQ[rr][0] = pack8(aQ, 0); zQ[rr][1] = pack8(aQ, 1);
    }
    f32x16 a1, a2, a3;
#pragma unroll
    for (int j = 0; j < 16; ++j) { a1[j] = 0.f; a2[j] = 0.f; a3[j] = 0.f; }
#pragma unroll
    for (int rr = 0; rr < 4; ++rr)
#pragma unroll
        for (int s = 0; s < 2; ++s) {
            const int kb = (rr * 32 + s * 16 + 4 * hh) * 2;
            const LAS unsigned char* rc = F.lds + FT_C128 + (rt * 32 + i) * 272 + kb; const LAS unsigned char* rs = F.lds + FT_S128 + (rt * 32 + i) * 272 + kb;
            const v2u cl = *(const LAS v2u*)rc, ch = *(const LAS v2u*)(rc + 16), sl = *(const LAS v2u*)rs, sh = *(const LAS v2u*)(rs + 16);
            const bf16x8 aC = __builtin_bit_cast(bf16x8, (v4u){cl.x, cl.y, ch.x, ch.y}), aS = __builtin_bit_cast(bf16x8, (v4u){sl.x, sl.y, sh.x, sh.y});
            a1 = __builtin_amdgcn_mfma_f32_32x32x16_bf16(aC, zP[rr][s], a1, 0, 0, 0); a2 = __builtin_amdgcn_mfma_f32_32x32x16_bf16(aS, zQ[rr][s], a2, 0, 0, 0);
            a3 = __builtin_amdgcn_mfma_f32_32x32x16_bf16(aC, zQ[rr][s], a3, 0, 0, 0); a3 = __builtin_amdgcn_mfma_f32_32x32x16_bf16(aS, zP[rr][s], a3, 0, 0, 0);
        }
    const int col = g * 64 + ct * 32 + i;
#pragma unroll
    for (int j = 0; j < 16; ++j) {
        const int ko = rt * 32 + (j & 3) + 8 * (j >> 2) + 4 * hh;
        const float Ar = a1[j] - a2[j], Ai = -a3[j];
        float s, c; sincospif((float)(n2 * ko) / 8192.0f, &s, &c);
        WSP(float, WS_BRE)[(size_t)(ko * 128 + n2) * 256 + col] = Ar * c + Ai * s;
        WSP(float, WS_BIM)[(size_t)(ko * 128 + n2) * 256 + col] = Ai * c - Ar * s;
    }
    __syncthreads();
}
__device__ __forceinline__ void fft2_unit(Frame& F, int k1, int cb) {
    const int tid = F.tid, wave = F.wave, lane = F.lane;
    LAS unsigned char* zr = F.lds + FT_DATA; LAS unsigned char* zi = zr + 64 * 272;
#pragma unroll
    for (int i = 0; i < 4; ++i) { const int id = tid + 512 * i, r = id >> 4, c4 = id & 15;
        const f32x4 vr = *(const f32x4*)(WSP(float, WS_BRE) + (size_t)(k1 * 128 + r) * 256 + cb * 64 + c4 * 4), vi = *(const f32x4*)(WSP(float, WS_BIM) + (size_t)(k1 * 128 + r) * 256 + cb * 64 + c4 * 4);
#pragma unroll
        for (int j = 0; j < 4; ++j) { *(LAS bf16*)(zr + (c4 * 4 + j) * 272 + r * 2) = (bf16)f2bf(vr[j]); *(LAS bf16*)(zi + (c4 * 4 + j) * 272 + r * 2) = (bf16)f2bf(vi[j]); } }
    __syncthreads();
    const int rt = wave & 3, ct = wave >> 2, i = lane & 31, hh = lane >> 5;
    f32x16 acc;
#pragma unroll
    for (int j = 0; j < 16; ++j) acc[j] = 0.f;
#pragma unroll
    for (int s = 0; s < 8; ++s) {
        const int ko = (s * 16 + hh * 8) * 2;
        const bf16x8 aC = *(const LAS bf16x8*)(F.lds + FT_C128 + (rt * 32 + i) * 272 + ko), aS = *(const LAS bf16x8*)(F.lds + FT_S128 + (rt * 32 + i) * 272 + ko);
        const bf16x8 bR = *(const LAS bf16x8*)(zr + (ct * 32 + i) * 272 + ko), bI = *(const LAS bf16x8*)(zi + (ct * 32 + i) * 272 + ko);
        acc = __builtin_amdgcn_mfma_f32_32x32x16_bf16(aC, bR, acc, 0, 0, 0); acc = __builtin_amdgcn_mfma_f32_32x32x16_bf16(aS, bI, acc, 0, 0, 0);
    }
    const int col = cb * 64 + ct * 32 + i;
#pragma unroll
    for (int j = 0; j < 16; ++j) { const int ko = rt * 32 + (j & 3) + 8 * (j >> 2) + 4 * hh;
        WSP(bf16, WS_AOUT)[(size_t)(NCTX + k1 + 128 * ko) * D + 768 + col] = (bf16)f2bf(acc[j] * (1.0f / 1024.0f)); }
    __syncthreads();
}
__device__ __forceinline__ void fft_ctx_unit(Frame& F, int g, int ct) {
    const int tid = F.tid, wave = F.wave, lane = F.lane;
    LAS float* Us = (LAS float*)F.lds; LAS float* Pl = Us + 256 * 64; LAS float* Ql = Pl + 256 * 32; const LAS float* tab = (const LAS float*)(F.lds + TAB_OFF);
    const bf16* U = WSP(bf16, WS_MQ + 4 * SEGB);
#pragma unroll
    for (int j = 0; j < 8; ++j) { const int id = tid + 512 * j, r = id >> 4, c4 = id & 15;
        const v2u vv = *(const v2u*)(U + (size_t)r * 256 + g * 64 + c4 * 4); const f32x4 v = {bf_lo(vv.x), bf_hi(vv.x), bf_lo(vv.y), bf_hi(vv.y)};
#pragma unroll
        for (int e = 0; e < 4; ++e) { const int c = c4 * 4 + e; Us[r * 64 + ((c & 32) | ((c ^ r) & 31))] = v[e]; } }
    __syncthreads();
    const int i = lane & 31, kk = lane >> 5, kr = wave * 32 + i;
    {
        f32x16 aP, aQ;
#pragma unroll
        for (int j = 0; j < 16; ++j) { aP[j] = 0.f; aQ[j] = 0.f; }
#pragma unroll 4
        for (int t = 0; t < 32; ++t) { const int c = 2 * t + kk, idx = (c * (ct * 32 + i)) & 63;
            const float a = Us[kr * 64 + ((c & 32) | ((c ^ kr) & 31))];
            aP = __builtin_amdgcn_mfma_f32_32x32x2f32(a, tab[4 * idx], aP, 0, 0, 0); aQ = __builtin_amdgcn_mfma_f32_32x32x2f32(a, tab[(4 * idx + 192) & 255], aQ, 0, 0, 0); }
#pragma unroll
        for (int j = 0; j < 16; ++j) { const int r = wave * 32 + (j & 3) + 8 * (j >> 2) + 4 * kk; Pl[r * 32 + i] = aP[j]; Ql[r * 32 + i] = aQ[j]; }
    }
    __syncthreads();
    f32x16 a1, a2;
#pragma unroll
    for (int j = 0; j < 16; ++j) { a1[j] = 0.f; a2[j] = 0.f; }
#pragma unroll 4
    for (int t = 0; t < 128; ++t) {
        const int n = 2 * t + kk, idx = (kr * n) & 255;
        a1 = __builtin_amdgcn_mfma_f32_32x32x2f32(tab[idx], Pl[n * 32 + i], a1, 0, 0, 0);
        a2 = __builtin_amdgcn_mfma_f32_32x32x2f32(tab[(idx + 192) & 255], Ql[n * 32 + i], a2, 0, 0, 0);
    }
#pragma unroll
    for (int j = 0; j < 16; ++j) {
        const int ko = wave * 32 + (j & 3) + 8 * (j >> 2) + 4 * kk;
        WSP(bf16, WS_AOUT)[(size_t)ko * D + 768 + g * 64 + ct * 32 + i] = (bf16)f2bf((a1[j] - a2[j]) * (1.0f / 128.0f));
    }
    __syncthreads();
}

__device__ __forceinline__ int ml_tc(int dir, int si) { return dir == 0 ? si : (si < 4 ? 3 - si : 263 - si); }
__device__ __forceinline__ int ml_row(int dir, int tc, int r) { return tc * 64 + (dir == 0 ? r : 63 - r); }
__device__ __forceinline__ void mlstm_a_phase(Frame& F) {
    const int wave = F.wave, lane = F.lane, dir = wave >> 2, wq = wave & 3, th = F.tid & 255;
    LAS float* ks = (LAS float*)(F.lds + dir * 49920); LAS float* wv = ks + 4160; LAS float* wl = wv + 4160;
    const float* gates = WSP(float, WS_GATES);
    const bf16* MK = WSP(bf16, WS_MQ + 1 * SEGB); const bf16* MV = WSP(bf16, WS_MQ + 2 * SEGB);
    v2u nku[4], nvu[4]; float nip = 0.f, nfp = 0.f;
#define MLA_LOAD(uu) do { const int head_ = (uu) & 3, tc_ = ml_tc(dir, (uu) >> 2); \
        _Pragma("unroll") for (int i = 0; i < 4; ++i) { const int id = th + 256 * i, r = id >> 4, c4 = id & 15; const size_t row = ml_row(dir, tc_, r); \
            nku[i] = *(const v2u*)(MK + row * 256 + head_ * 64 + c4 * 4); nvu[i] = *(const v2u*)(MV + row * 256 + head_ * 64 + c4 * 4); } \
        if (wq == 0) { const int row = ml_row(dir, tc_, lane); nip = gates[(size_t)row * 16 + dir * 4 + head_]; nfp = gates[(size_t)row * 16 + (2 + dir) * 4 + head_]; } } while (0)
    int u = F.bid;
    if (u < 4 * NCH) MLA_LOAD(u);
#pragma unroll 1
    for (; u < 4 * NCH; u += F.G) {
        const int head = u & 3, si = u >> 2;
        v2u ku[4], vu[4];
#pragma unroll
        for (int i = 0; i < 4; ++i) { ku[i] = nku[i]; vu[i] = nvu[i]; }
        const float ip = nip, fp = nfp;
        if (u + F.G < 4 * NCH) MLA_LOAD(u + F.G);
        float* CL = WSP(float, WS_CL) + ((size_t)(dir * 4 + head) * NCH + si) * 4160;
        if (wq == 0) {
            const float b = wave_scan_sum(logsigmoidf_(fp));
            const float g = __builtin_bit_cast(float, __builtin_amdgcn_readlane(__builtin_bit_cast(int, b), 63));
            const float a = g - b + ip;
            const float mloc = __builtin_bit_cast(float, __builtin_amdgcn_readlane(__builtin_bit_cast(int, wave_scan_max(a)), 63));
            wl[lane] = __expf(a - mloc);
            if (lane == 0) { float* sc = WSP(float, WS_SCAL) + ((size_t)(dir * 4 + head) * NCH + si) * 4; sc[0] = mloc; sc[1] = g; }
        }
        __syncthreads();
#pragma unroll
        for (int i = 0; i < 4; ++i) { const int id = th + 256 * i, r = id >> 4, c4 = id & 15;
            const f32x4 kv = {bf_lo(ku[i].x), bf_hi(ku[i].x), bf_lo(ku[i].y), bf_hi(ku[i].y)}, vv = {bf_lo(vu[i].x), bf_hi(vu[i].x), bf_lo(vu[i].y), bf_hi(vu[i].y)}; const float w = wl[r];
#pragma unroll
            for (int j = 0; j < 4; ++j) { ks[r * 65 + c4 * 4 + j] = kv[j]; wv[r * 65 + c4 * 4 + j] = vv[j] * w; } }
        __syncthreads();
        {
            const int vt = wq >> 1, kt = wq & 1, i = lane & 31, kk = lane >> 5;
            f32x16 acc;
#pragma unroll
            for (int j = 0; j < 16; ++j) acc[j] = 0.f;
#pragma unroll 8
            for (int t = 0; t < 32; ++t) acc = __builtin_amdgcn_mfma_f32_32x32x2f32(wv[(2 * t + kk) * 65 + vt * 32 + i], ks[(2 * t + kk) * 65 + kt * 32 + i], acc, 0, 0, 0);
#pragma unroll
            for (int j = 0; j < 16; ++j) { const int v = vt * 32 + (j & 3) + 8 * (j >> 2) + 4 * kk; CL[v * 64 + kt * 32 + i] = acc[j]; }
            if (wq == 0) { float n = 0.f;
                for (int r = 0; r < 64; ++r) n += wl[r] * ks[r * 65 + lane];
                CL[4096 + lane] = n; }
        }
        __syncthreads();
    }
#undef MLA_LOAD
}
__device__ __forceinline__ void mlstm_scan_wave(Frame& F, int item) {
    const int dh = item / 65, eg = item % 65, e = eg * 64 + F.lane;
    LAS float* sc = (LAS float*)(F.lds + F.wave * 4096);
    float* SC = WSP(float, WS_SCAL) + (size_t)dh * NCH * 4;
    for (int i = F.lane; i < NCH; i += 64) { const f32x4 v = *(const f32x4*)(SC + i * 4); sc[2 * i] = v[0]; sc[2 * i + 1] = v[1]; }
    LDS_WAIT(); asm volatile("" ::: "memory");
    const float* src = WSP(float, WS_CL) + (size_t)dh * NCH * 4160 + e; float* dst = WSP(float, WS_C0) + (size_t)dh * NCH * 4160 + e;
    float C = 0.f, m = 0.f;
    float xa[20], xb[20];
#define SCAN_LOAD(x_, s_) do { _Pragma("unroll") for (int j = 0; j < 20; ++j) x_[j] = src[(size_t)((s_) + j) * 4160]; } while (0)
#define SCAN_RUN(x_, s_) do { _Pragma("unroll") for (int j = 0; j < 20; ++j) { \
            const float mloc = sc[2 * ((s_) + j)], g = sc[2 * ((s_) + j) + 1]; \
            const float mn = fmaxf(g + m, mloc); \
            dst[(size_t)((s_) + j) * 4160] = C; \
            if (eg == 0 && F.lane == 0) SC[((s_) + j) * 4 + 2] = m; \
            C = __expf(g + m - mn) * C + __expf(mloc - mn) * x_[j]; m = mn; } } while (0)
    SCAN_LOAD(xa, 0);
#pragma unroll 1
    for (int s0 = 0; s0 < NCH; s0 += 40) {
        if (s0 + 20 < NCH) SCAN_LOAD(xb, s0 + 20);
        SCAN_RUN(xa, s0);
        if (s0 + 40 < NCH) SCAN_LOAD(xa, s0 + 40);
        if (s0 + 20 < NCH) SCAN_RUN(xb, s0 + 20);
    }
#undef SCAN_LOAD
#undef SCAN_RUN
}
constexpr int ML_ROWB = 144, ML_TILE = 64 * ML_ROWB, ML_DSZ = 4 * ML_TILE + 1280, ML_HS = 2 * ML_DSZ;
__device__ __forceinline__ void mlstm_out_phase(Frame& F, int l, int c_lo) {
    const int tid = F.tid, wave = F.wave, lane = F.lane, dir = wave >> 2, wq = wave & 3, th = tid & 255, i = lane & 31, hh = lane >> 5;
    LAS unsigned char* db = F.lds + dir * ML_DSZ;
    LAS unsigned char* qb = db; LAS unsigned char* kb = db + ML_TILE; LAS unsigned char* vt = db + 2 * ML_TILE; LAS unsigned char* cb = db + 3 * ML_TILE;
    LAS float* sm = (LAS float*)(db + 4 * ML_TILE); LAS float* bb = sm; LAS float* ib = sm + 64; LAS float* mr = sm + 128; LAS float* ei = sm + 192; LAS float* n0 = sm + 256;
    LAS float* hs = (LAS float*)(F.lds + ML_HS) + dir * 4160;
    const float* gates = WSP(float, WS_GATES);
    const bf16* MQ = WSP(bf16, WS_MQ); const bf16* MK = WSP(bf16, WS_MQ + 1 * SEGB); const bf16* MV = WSP(bf16, WS_MQ + 2 * SEGB); const bf16* MO = WSP(bf16, WS_MQ + 3 * SEGB);
    const int NU = 4 * (NCH - c_lo);
    v2u nq[4], nk[4], nv[4]; f32x4 nc[4]; float nip = 0.f, nfp = 0.f, nm0 = 0.f, nn0 = 0.f;
#define MLO_LOAD(uu) do { const int head_ = (uu) & 3, tc_ = c_lo + ((uu) >> 2); const int si_ = dir == 0 ? tc_ : (tc_ < 4 ? 3 - tc_ : 263 - tc_); const size_t sb_ = (size_t)(dir * 4 + head_) * NCH + si_; \
        _Pragma("unroll") for (int j4 = 0; j4 < 4; ++j4) { const int id = th + 256 * j4, r = id >> 4, c4 = id & 15; const size_t row = ml_row(dir, tc_, r); \
            nq[j4] = *(const v2u*)(MQ + row * 256 + head_ * 64 + c4 * 4); nk[j4] = *(const v2u*)(MK + row * 256 + head_ * 64 + c4 * 4); nv[j4] = *(const v2u*)(MV + row * 256 + head_ * 64 + c4 * 4); \
            nc[j4] = *(const f32x4*)(WSP(float, WS_C0) + sb_ * 4160 + r * 64 + c4 * 4); } \
        if (wq == 0) { const int row = ml_row(dir, tc_, lane); nip = gates[(size_t)row * 16 + dir * 4 + head_]; nfp = gates[(size_t)row * 16 + (2 + dir) * 4 + head_]; \
            nm0 = WSP(float, WS_SCAL)[sb_ * 4 + 2]; nn0 = WSP(float, WS_C0)[sb_ * 4160 + 4096 + lane]; } } while (0)
    int u = F.bid;
    if (u < NU) MLO_LOAD(u);
#pragma unroll 1
    for (; u < NU; u += F.G) {
        const int head = u & 3, tc = c_lo + (u >> 2);
        v2u cq[4], ck[4], cvv[4]; f32x4 cc[4];
#pragma unroll
        for (int j4 = 0; j4 < 4; ++j4) { cq[j4] = nq[j4]; ck[j4] = nk[j4]; cvv[j4] = nv[j4]; cc[j4] = nc[j4]; }
        const float ip = nip, fp = nfp, m0 = nm0, n0v = nn0;
        if (u + F.G < NU) MLO_LOAD(u + F.G);
        if (wq == 0) {
            const float b = wave_scan_sum(logsigmoidf_(fp));
            const float d = ip - b; const float pm = wave_scan_max(d);
            const float mrow = b + fmaxf(m0, pm);
            bb[lane] = b; ib[lane] = d; mr[lane] = mrow; ei[lane] = __expf(b + m0 - mrow);
            n0[lane] = n0v;
        }
#pragma unroll
        for (int j4 = 0; j4 < 4; ++j4) { const int id = th + 256 * j4, r = id >> 4, c4 = id & 15;
            const v2u qv = cq[j4], kv = ck[j4], vv = cvv[j4]; const f32x4 cv = cc[j4];
            *(LAS v2u*)(qb + r * ML_ROWB + c4 * 8) = qv;
            *(LAS v2u*)(kb + r * ML_ROWB + c4 * 8) = kv;
            *(LAS v2u*)(cb + r * ML_ROWB + c4 * 8) = (v2u){pk2(cv[0], cv[1]), pk2(cv[2], cv[3])};
            *(LAS bf16*)(vt + (c4 * 4 + 0) * ML_ROWB + r * 2) = (bf16)(vv.x & 0xffffu); *(LAS bf16*)(vt + (c4 * 4 + 1) * ML_ROWB + r * 2) = (bf16)(vv.x >> 16);
            *(LAS bf16*)(vt + (c4 * 4 + 2) * ML_ROWB + r * 2) = (bf16)(vv.y & 0xffffu); *(LAS bf16*)(vt + (c4 * 4 + 3) * ML_ROWB + r * 2) = (bf16)(vv.y >> 16); }
        const int te = tid >> 3, vge = (tid & 7) * 8; const size_t rowe = (size_t)tc * 64 + te;
        const v4u ou = *(const v4u*)(MO + rowe * 256 + head * 64 + vge);
        const f32x4 nwa = *(const f32x4*)(F.in[I_MNW] + (size_t)l * 256 + head * 64 + vge), nwb = *(const f32x4*)(F.in[I_MNW] + (size_t)l * 256 + head * 64 + vge + 4);
        __syncthreads();
        {
            const int vtile = wq >> 1, ttile = wq & 1, t = ttile * 32 + i;
            const float bt = bb[t], mt = mr[t], et = ei[t];
            bf16x8 pS[2][2]; float dsum = 0.f;
#pragma unroll
            for (int st = 0; st < 2; ++st) {
                f32x16 acc;
#pragma unroll
                for (int j = 0; j < 16; ++j) acc[j] = 0.f;
#pragma unroll
                for (int ks = 0; ks < 4; ++ks) {
                    const bf16x8 a = *(const LAS bf16x8*)(kb + (st * 32 + i) * ML_ROWB + (ks * 16 + hh * 8) * 2), b = *(const LAS bf16x8*)(qb + t * ML_ROWB + (ks * 16 + hh * 8) * 2);
                    acc = __builtin_amdgcn_mfma_f32_32x32x16_bf16(a, b, acc, 0, 0, 0);
                }
#pragma unroll
                for (int j = 0; j < 16; ++j) { const int s_ = st * 32 + (j & 3) + 8 * (j >> 2) + 4 * hh;
                    const float w = (s_ <= t) ? __expf(bt + ib[s_] - mt) : 0.f; acc[j] *= w; dsum += acc[j]; }
                pS[st][0] = pack8(acc, 0); pS[st][1] = pack8(acc, 1);
            }
            dsum += shx(dsum, lane, 32);
            f32x16 num, G;
#pragma unroll
            for (int j = 0; j < 16; ++j) { num[j] = 0.f; G[j] = 0.f; }
#pragma unroll
            for (int st = 0; st < 2; ++st)
#pragma unroll
                for (int s2 = 0; s2 < 2; ++s2) {
                    const LAS unsigned char* vr = vt + (vtile * 32 + i) * ML_ROWB + (st * 32 + s2 * 16 + 4 * hh) * 2;
                    const v2u lo = *(const LAS v2u*)vr, hi = *(const LAS v2u*)(vr + 16);
                    num = __builtin_amdgcn_mfma_f32_32x32x16_bf16(__builtin_bit_cast(bf16x8, (v4u){lo.x, lo.y, hi.x, hi.y}), pS[st][s2], num, 0, 0, 0);
                }
#pragma unroll
            for (int ks = 0; ks < 4; ++ks) {
                const bf16x8 a = *(const LAS bf16x8*)(cb + (vtile * 32 + i) * ML_ROWB + (ks * 16 + hh * 8) * 2), b = *(const LAS bf16x8*)(qb + t * ML_ROWB + (ks * 16 + hh * 8) * 2);
                G = __builtin_amdgcn_mfma_f32_32x32x16_bf16(a, b, G, 0, 0, 0);
            }
            float dn = 0.f;
#pragma unroll
            for (int c = 0; c < 8; ++c) { const v4u qv = *(const LAS v4u*)(qb + t * ML_ROWB + c * 16);
                dn += n0[c * 8 + 0] * bf_lo(qv.x) + n0[c * 8 + 1] * bf_hi(qv.x) + n0[c * 8 + 2] * bf_lo(qv.y) + n0[c * 8 + 3] * bf_hi(qv.y) + n0[c * 8 + 4] * bf_lo(qv.z) + n0[c * 8 + 5] * bf_hi(qv.z) + n0[c * 8 + 6] * bf_lo(qv.w) + n0[c * 8 + 7] * bf_hi(qv.w); }
            const float den = dsum + et * dn; const float rden = 1.0f / fmaxf(fabsf(den), __expf(-mt));
            const int tl = dir == 0 ? t : 63 - t;
#pragma unroll
            for (int j = 0; j < 16; ++j) { const int v = vtile * 32 + (j & 3) + 8 * (j >> 2) + 4 * hh; hs[tl * 65 + v] = (num[j] + et * G[j]) * rden; }
        }
        __syncthreads();
        {
            const LAS float* h0 = (const LAS float*)(F.lds + ML_HS); const LAS float* h1 = h0 + 4160;
            float x[8]; float ss = 0.f;
#pragma unroll
            for (int j = 0; j < 8; ++j) { x[j] = h0[te * 65 + vge + j] + h1[te * 65 + vge + j]; ss += x[j] * x[j]; }
            ss += dpp0<0xB1, 0xf, 0xf>(ss); ss += dpp0<0x4E, 0xf, 0xf>(ss); ss += dppo<0x114, 0xf, 0xa>(dpp0<0x104, 0xf, 0x5>(ss), ss);
            const float r = rsqrtf(ss * (1.0f / 64.0f) + LN_EPS);
            const float op[8] = {bf_lo(ou.x), bf_hi(ou.x), bf_lo(ou.y), bf_hi(ou.y), bf_lo(ou.z), bf_hi(ou.z), bf_lo(ou.w), bf_hi(ou.w)};
            const float nw[8] = {nwa[0], nwa[1], nwa[2], nwa[3], nwb[0], nwb[1], nwb[2], nwb[3]};
            float y[8];
#pragma unroll
            for (int j = 0; j < 8; ++j) y[j] = x[j] * r * nw[j] * sigmoidf_(op[j]);
            v4u w; w.x = pk2(y[0], y[1]); w.y = pk2(y[2], y[3]); w.z = pk2(y[4], y[5]); w.w = pk2(y[6], y[7]);
            *(v4u*)(WSP(bf16, WS_AOUT) + rowe * D + 512 + head * 64 + vge) = w;
        }
        __syncthreads();
    }
#undef MLO_LOAD
}

constexpr int N_PHASES = 1 + 11 * DEPTH;
__device__ __forceinline__ float lam_init_of(int l) { return l == 0 ? 0.2f : 0.35550906f; }

__global__ void __launch_bounds__(512, 2) mk_fwd(Args args) {
    extern __shared__ __attribute__((aligned(16))) unsigned char lds_raw[];
    Frame F;
    F.lds = (LAS unsigned char*)lds_raw;
    F.MISC = (volatile LAS int*)(F.lds + MISC_OFF);
    const int wave_s = __builtin_amdgcn_readfirstlane((int)threadIdx.x >> 6);
    F.tid = threadIdx.x; F.lane = F.tid & 63; F.wave = wave_s;
    F.G = gridDim.x; F.bid = blockIdx.x;
    F.ws = args.ws; F.in = args.in; F.out = args.out;
    for (int u = F.tid; u < 256; u += 512) F.MISC[u] = 0;
    __syncthreads();
#if MK_SINGLE
    XcdBarrier bar = xcd_barrier_post(WSP(unsigned, WS_CTL) + CW_BAR, (volatile LAS unsigned*)(F.MISC + 200));
#define GRID_BAR() do { PH_BEGIN(); xcd_barrier(bar, F.tid); } while (0)
#else
#define GRID_BAR() do {} while (0)
#endif
    const int lo = args.ph_lo, hi = args.ph_hi;
#ifndef ONLY_SP
#define ONLY_SP -1
#endif
#ifndef REP_P0
#define REP_P0 1
#endif
#ifndef ATT_PROBE
#define ATT_PROBE 0
#endif
#ifndef REP_ATT
#define REP_ATT 1
#endif
#ifndef REP_MLA
#define REP_MLA 1
#endif
#ifndef REP_F1
#define REP_F1 1
#endif
#ifndef REP_FM
#define REP_FM 1
#endif
#ifndef REP_SP3
#define REP_SP3 1
#endif
#ifndef REP_SP4
#define REP_SP4 1
#endif
#ifndef NULL_G8
#define NULL_G8 0
#endif
#ifndef NULL_G1
#define NULL_G1 0
#endif
#ifndef REP_G1
#define REP_G1 1
#endif
#ifndef REP_G5
#define REP_G5 1
#endif
#ifndef REP_G8
#define REP_G8 1
#endif
#ifndef REP_G9
#define REP_G9 1
#endif
#ifndef REP_GA
#define REP_GA 1
#endif
#ifndef SPV_G1A
#define SPV_G1A 1
#define SPV_G1B 1
#endif
#ifndef SPV_ATT
#define SPV_ATT 1
#define SPV_CTXF 1
#define SPV_FFT1 1
#define SPV_MLA 1
#endif
#define SP_ON(sp) (ONLY_SP < 0 || ONLY_SP == (sp))
#define PH_BEGIN() do { int w_ = wave_s; unsigned on_ = ~0u; asm volatile("" : "+s"(w_), "+s"(on_)); int t_ = w_ * 64 + (int)__builtin_amdgcn_mbcnt_hi(on_, __builtin_amdgcn_mbcnt_lo(on_, 0u)); asm volatile("" : "+v"(t_)); F.tid = t_; F.lane = t_ & 63; F.wave = w_; } while (0)
#ifndef REP_R0
#define REP_R0 1
#endif
#ifndef REP_R1
#define REP_R1 1
#endif
#ifndef REP_R2
#define REP_R2 1
#endif
#ifndef REP_R2L
#define REP_R2L 1
#endif
#ifndef REP_BAR
#define REP_BAR 1
#endif
#define PH_END(ph) do { if ((ph) + 1 < hi) { for (int rb_ = 0; rb_ < REP_BAR; ++rb_) GRID_BAR(); } } while (0)
    if (lo <= 0 && 0 < hi) { PH_BEGIN(); if (SP_ON(100)) { for (int rep = 0; rep < REP_P0; ++rep) { p0_prologue(F); __syncthreads(); } } PH_END(0); }
#pragma unroll 1
    for (int l = 0; l < DEPTH; ++l) {
        const int pb = 1 + 11 * l;
        if (lo <= pb + 0 && pb + 0 < hi) { PH_BEGIN(); if (SP_ON(0)) { if (l == 0) for (int rep = 0; rep < REP_R0; ++rep) row_phase<0, false>(F, 0); } PH_END(pb + 0); }
        if (lo <= pb + 1 && pb + 1 < hi) { PH_BEGIN(); if (SP_ON(1)) {
                if (NULL_G1) { pg8::Gemm g{WSP(bf16, WS_H), WSP(bf16, WS_WIN) + (size_t)l * 2560 * D, T, 2304, D}; pg8::StaticOrder S; S.init(T, 2304, F.G, F.bid);
                  pg8::EpiNull E{WSP(float, WS_XG)};
                  pg8::gemm_phase<pg8::EpiNull, pg8::StaticOrder, true, true>(F.lds, g, S, E, F.tid);
                  __syncthreads(); PH_BEGIN(); }
                for (int rep = 0; rep < REP_G1; ++rep) {
                { pg8::Gemm g{WSP(bf16, WS_H), WSP(bf16, WS_WIN) + (size_t)l * 2560 * D, T, 2304, D, nullptr, WSP(bf16, WS_WV) + (size_t)l * 512 * D, WSP(bf16, WS_H)};
                  pg8::InProjOrder S; S.s1.init(T, 2304, F.G, F.bid); S.s2.init(512, T, F.G, F.bid); S.G = F.G; S.c = F.bid;
                  pg8::EpiInProjAll E{pg8::EpiInProj{WSP(bf16, WS_QB), WSP(bf16, WS_KB), WSP(float, WS_MQ), WSP(float, WS_ROPE), WSP(unsigned, WS_CTL) + CW_KINF + l * 16}, pg8::EpiVt{WSP(bf16, WS_VT)}};
                  pg8::gemm_phase<pg8::EpiInProjAll, pg8::InProjOrder, true, true>(F.lds, g, S, E, F.tid); }
                __syncthreads();
                }
            } PH_END(pb + 1); }
        if (lo <= pb + 2 && pb + 2 < hi) { PH_BEGIN(); if (SP_ON(2)) {
                float lam;
                { const float* dl = F.in[I_DLAM] + (size_t)l * 256;
                  const float s1 = wave_sum(dl[F.lane] * dl[64 + F.lane], F.lane), s2 = wave_sum(dl[128 + F.lane] * dl[192 + F.lane], F.lane);
                  lam = expf(s1) - expf(s2) + lam_init_of(l); }
                const float oml = 1.0f - lam_init_of(l);
                const int n_cx = (l == 0 ? 8 : 0), n_cd = (l == 0 ? 8 : 0);
                if (ATT_PROBE) {
#pragma unroll 1
                for (int u = F.bid; u < 512 + n_cx; u += F.G) { const bool lat = u < 512; const int v = lat ? u : u - 512; attn_unit<ATT_PROBE>(F, l, v & 3, (lat ? 2 : 0) + (v >> 2), lat ? NCH : 4, lam, oml); } }
                if (ATT_PROBE) { __syncthreads(); PH_BEGIN(); }
                if (SPV_ATT) for (int rep = 0; rep < REP_ATT; ++rep) {
#pragma unroll 1
                for (int u = F.bid; u < 512 + n_cx; u += F.G) { const bool lat = u < 512; const int v = lat ? u : u - 512; attn_unit<0>(F, l, v & 3, (lat ? 2 : 0) + (v >> 2), lat ? NCH : 4, lam, oml); } }
                for (int rep2 = 0; rep2 < REP_FM; ++rep2) {
                PH_BEGIN();
                fft_tab256(F);
                if (SPV_CTXF) {
#pragma unroll 1
                for (int u = F.bid - 8; u < n_cd; u += F.G) if (u >= 0) fft_ctx_unit(F, u >> 1, u & 1); }
                PH_BEGIN();
                if (SPV_FFT1) for (int rep4 = 0; rep4 < REP_F1; ++rep4) { fft_tables(F);
#pragma unroll 1
                for (int u = F.bid; u < 512; u += F.G) fft1_unit(F, u >> 2, u & 3); }
                PH_BEGIN();
                if (SPV_MLA) for (int rep3 = 0; rep3 < REP_MLA; ++rep3) {
                mlstm_a_phase(F); } }
            } PH_END(pb + 2); }
        if (lo <= pb + 3 && pb + 3 < hi) { PH_BEGIN(); if (SP_ON(3)) {
                for (int rep = 0; rep < REP_SP3; ++rep) {
                for (int it = F.wave * F.G + F.bid; it < 520; it += 8 * F.G) mlstm_scan_wave(F, it);
                __syncthreads();
                fft_tables(F);
#pragma unroll 1
                for (int u = F.bid; u < 512; u += F.G) fft2_unit(F, u >> 2, u & 3); }
            } PH_END(pb + 3); }
        if (lo <= pb + 4 && pb + 4 < hi) { PH_BEGIN(); if (SP_ON(4)) {
                const int c_lo = (l == 0) ? 0 : 4;
                for (int rep = 0; rep < REP_SP4; ++rep)
                mlstm_out_phase(F, l, c_lo);
            } PH_END(pb + 4); }
        if (lo <= pb + 5 && pb + 5 < hi) { PH_BEGIN(); if (SP_ON(5)) {
                const int r0 = (l == 0) ? 0 : NCTX;
                for (int rep = 0; rep < REP_G5; ++rep) {
                pg8::Gemm g{WSP(bf16, WS_AOUT) + (size_t)r0 * D, WSP(bf16, WS_WOUT) + (size_t)l * D * D, T - r0, D, D}; pg8::StaticOrder S; S.init(T - r0, D, F.G, F.bid);
                pg8::EpiBf16Plain E{WSP(bf16, WS_MIX) + (size_t)r0 * D, D};
                pg8::gemm_phase<pg8::EpiBf16Plain, pg8::StaticOrder, true, true>(F.lds, g, S, E, F.tid);
                __syncthreads();
                }
            } PH_END(pb + 5); }
        if (lo <= pb + 6 && pb + 6 < hi) { PH_BEGIN(); if (SP_ON(6)) { for (int rep = 1; rep < REP_R1; ++rep) row_phase<1, false>(F, l, true); row_phase<1, false>(F, l); } PH_END(pb + 6); }
        if (lo <= pb + 7 && pb + 7 < hi) { PH_BEGIN(); if (SP_ON(7)) { for (int rep = 0; rep < REP_GA; ++rep) { moe_gather(F, l); __syncthreads(); } } PH_END(pb + 7); }
        if (lo <= pb + 8 && pb + 8 < hi) { PH_BEGIN(); if (SP_ON(8)) {
                if (NULL_G8) { moe_prefix(F, l, 8);
                  pg8::Gemm g{WSP(bf16, WS_F), WSP(bf16, WS_WGU) + (size_t)l * NE * 2048 * D, SLOT_ROWS, NE * 2048, D, WSP(int, WS_SROW)};
                  pg8::MoeOrder S{(const volatile LAS int*)F.MISC, (const volatile LAS int*)F.MISC + 64, (const volatile LAS int*)F.MISC + 128, 8, F.G, F.bid};
                  pg8::EpiNull E{WSP(float, WS_XG)};
                  pg8::gemm_phase<pg8::EpiNull, pg8::MoeOrder, true, true, true>(F.lds, g, S, E, F.tid);
                  __syncthreads(); PH_BEGIN(); }
                for (int rep = 0; rep < REP_G8; ++rep) {
                moe_prefix(F, l, 8);
                pg8::Gemm g{WSP(bf16, WS_F), WSP(bf16, WS_WGU) + (size_t)l * NE * 2048 * D, SLOT_ROWS, NE * 2048, D, WSP(int, WS_SROW)};
                pg8::MoeOrder S{(const volatile LAS int*)F.MISC, (const volatile LAS int*)F.MISC + 64, (const volatile LAS int*)F.MISC + 128, 8, F.G, F.bid};
                pg8::EpiSwiglu E{WSP(bf16, WS_ACT), F.in[I_BGU] + (size_t)l * NE * 2048};
                pg8::gemm_phase<pg8::EpiSwiglu, pg8::MoeOrder, true, true, true>(F.lds, g, S, E, F.tid);
                __syncthreads();
                }
            } PH_END(pb + 8); }
        if (lo <= pb + 9 && pb + 9 < hi) { PH_BEGIN(); if (SP_ON(9)) {
                for (int rep = 0; rep < REP_G9; ++rep) {
                moe_prefix(F, l, 4);
                pg8::Gemm g{WSP(bf16, WS_ACT), WSP(bf16, WS_WDN) + (size_t)l * NE * D * D, SLOT_ROWS, NE * D, D};
                pg8::MoeOrder S{(const volatile LAS int*)F.MISC, (const volatile LAS int*)F.MISC + 64, (const volatile LAS int*)F.MISC + 128, 4, F.G, F.bid};
                pg8::EpiDown E{WSP(bf16, WS_YB), F.in[I_BD] + (size_t)l * NE * D, WSP(float, WS_SG)};
                pg8::gemm_phase<pg8::EpiDown, pg8::MoeOrder, true, true>(F.lds, g, S, E, F.tid);
                __syncthreads();
                }
            } PH_END(pb + 9); }
        if (lo <= pb + 10 && pb + 10 < hi) { PH_BEGIN(); if (SP_ON(10)) { if (l == DEPTH - 1) { for (int rep = 0; rep < REP_R2L; ++rep) row_phase<2, true>(F, l); } else { for (int rep = 1; rep < REP_R2; ++rep) row_phase<2, false>(F, l, true); row_phase<2, false>(F, l); } } PH_END(pb + 10); }
    }
}

extern "C" void kernel_launch(void* const* d_in, const int* in_sizes, int n_in, void* d_out, int out_size, void* d_ws, size_t ws_size, hipStream_t stream) {
    static int grid = 0;
    if (grid == 0) {
        if (n_in != 22 || out_size != SEQ * D || ws_size < WS_END) { fprintf(stderr, "kernel_launch: unexpected shapes (n_in %d, out %d, ws %zu < %zu)\n", n_in, out_size, ws_size, (size_t)WS_END); grid = -1; return; }
        int dev = 0, cus = 0, per_cu = 0;
        if (hipGetDevice(&dev) != hipSuccess || hipDeviceGetAttribute(&cus, hipDeviceAttributeMultiprocessorCount, dev) != hipSuccess) { grid = -1; return; }
        if (hipFuncSetAttribute((const void*)mk_fwd, hipFuncAttributeMaxDynamicSharedMemorySize, LDS_BYTES) != hipSuccess) { fprintf(stderr, "kernel_launch: hipFuncSetAttribute failed\n"); grid = -1; return; }
        if (hipOccupancyMaxActiveBlocksPerMultiprocessor(&per_cu, (const void*)mk_fwd, 512, LDS_BYTES) != hipSuccess || per_cu < 1) { fprintf(stderr, "kernel_launch: occupancy query reports %d\n", per_cu); }
        (void)hipGetLastError();
        grid = cus;
    }
    if (grid < 0) return;
    (void)hipMemsetAsync((char*)d_ws + WS_CTL, 0, CTL_ZERO_BYTES, stream);
    Args a{};
    for (int i = 0; i < 22; ++i) a.in[i] = (const float*)d_in[i];
    a.out = (float*)d_out; a.ws = (unsigned char*)d_ws;
#if MK_SINGLE
    a.ph_lo = 0; a.ph_hi = N_PHASES;
    hipLaunchKernelGGL(mk_fwd, dim3(grid), dim3(512), LDS_BYTES, stream, a);
#else
    for (int ph = 0; ph < N_PHASES; ++ph) {
        if (ph == 12) continue;
        a.ph_lo = ph; a.ph_hi = ph + 1;
        hipLaunchKernelGGL(mk_fwd, dim3(grid), dim3(512), LDS_BYTES, stream, a);
    }
#endif
}
```

```cpp
#include <hip/hip_runtime.h>
#include <cstdio>
#include <cstdint>
#include <cmath>

#ifndef MK_SINGLE
#define MK_SINGLE 1
#endif

constexpr int D = 1024, SEQ = 16384, NCTX = 256, T = SEQ + NCTX, DEPTH = 2, INW = 2832;
constexpr int NE = 32, TOPK = 4, NCH = 260;
constexpr int SLOT_ROWS = 74752;
constexpr float LN_EPS = 1e-5f;
constexpr float DN_ALPHA = 1.41421356237f;
constexpr float QSCALE = 0.125f * 1.44269504089f;

#define GAS __attribute__((address_space(1)))
#define LAS __attribute__((address_space(3)))
typedef unsigned short bf16;
typedef unsigned v4u __attribute__((ext_vector_type(4)));
typedef unsigned v2u __attribute__((ext_vector_type(2)));
typedef float f32x4 __attribute__((ext_vector_type(4)));
typedef float f32x16 __attribute__((ext_vector_type(16)));
typedef short bf16x8 __attribute__((ext_vector_type(8)));
typedef short s16x4 __attribute__((ext_vector_type(4)));
typedef GAS unsigned gu32;
#define RLX_AGENT __ATOMIC_RELAXED, __HIP_MEMORY_SCOPE_AGENT
#define LDS_WAIT() asm volatile("s_waitcnt lgkmcnt(0)" ::: "memory")
#define VM_WAIT() asm volatile("s_waitcnt vmcnt(0)" ::: "memory")

typedef __bf16 bf2_t __attribute__((ext_vector_type(2)));
__device__ __forceinline__ unsigned f2bf(float f) { return (unsigned)__builtin_bit_cast(unsigned short, (__bf16)f); }
__device__ __forceinline__ unsigned pk2(float lo, float hi) { bf2_t v = {(__bf16)lo, (__bf16)hi}; return __builtin_bit_cast(unsigned, v); }
__device__ __forceinline__ float bf_lo(unsigned u) { return __builtin_bit_cast(float, u << 16); }
__device__ __forceinline__ float bf_hi(unsigned u) { return __builtin_bit_cast(float, u & 0xffff0000u); }
__device__ __forceinline__ float shx(float v, int lane, int mask) { return __builtin_bit_cast(float, __builtin_amdgcn_ds_bpermute((lane ^ mask) << 2, __builtin_bit_cast(int, v))); }
__device__ __forceinline__ int shxi(int v, int lane, int mask) { return __builtin_amdgcn_ds_bpermute((lane ^ mask) << 2, v); }
__device__ __forceinline__ float shup(float v, int lane, int d) { return __builtin_bit_cast(float, __builtin_amdgcn_ds_bpermute((lane - d) << 2, __builtin_bit_cast(int, v))); }
__device__ __forceinline__ float wave_sum(float v, int lane) {
#pragma unroll
    for (int o = 1; o < 64; o <<= 1) v += shx(v, lane, o);
    return v;
}
__device__ __forceinline__ float wave_max(float v, int lane) {
#pragma unroll
    for (int o = 1; o < 64; o <<= 1) v = fmaxf(v, shx(v, lane, o));
    return v;
}
template <int CTRL, int RM, int BM>
__device__ __forceinline__ float dpp0(float v) { return __builtin_bit_cast(float, __builtin_amdgcn_update_dpp(0, __builtin_bit_cast(int, v), CTRL, RM, BM, true)); }
template <int CTRL, int RM, int BM>
__device__ __forceinline__ float dppo(float old, float v) { return __builtin_bit_cast(float, __builtin_amdgcn_update_dpp(__builtin_bit_cast(int, old), __builtin_bit_cast(int, v), CTRL, RM, BM, false)); }
__device__ __forceinline__ float wave_sum_u(float v) {
    v += dpp0<0x111, 0xf, 0xf>(v); v += dpp0<0x112, 0xf, 0xf>(v); v += dpp0<0x114, 0xf, 0xf>(v); v += dpp0<0x118, 0xf, 0xf>(v);
    v += dpp0<0x142, 0xa, 0xf>(v); v += dpp0<0x143, 0xc, 0xf>(v);
    return __builtin_bit_cast(float, __builtin_amdgcn_readlane(__builtin_bit_cast(int, v), 63));
}
__device__ __forceinline__ float wave_scan_sum(float v) {
    v += dpp0<0x111, 0xf, 0xf>(v); v += dpp0<0x112, 0xf, 0xf>(v); v += dpp0<0x114, 0xf, 0xf>(v); v += dpp0<0x118, 0xf, 0xf>(v);
    v += dpp0<0x142, 0xa, 0xf>(v); v += dpp0<0x143, 0xc, 0xf>(v);
    return v;
}
__device__ __forceinline__ float wave_scan_max(float v) {
    const float ninf = -INFINITY;
    v = fmaxf(v, dppo<0x111, 0xf, 0xf>(ninf, v)); v = fmaxf(v, dppo<0x112, 0xf, 0xf>(ninf, v)); v = fmaxf(v, dppo<0x114, 0xf, 0xf>(ninf, v)); v = fmaxf(v, dppo<0x118, 0xf, 0xf>(ninf, v));
    v = fmaxf(v, dppo<0x142, 0xa, 0xf>(ninf, v)); v = fmaxf(v, dppo<0x143, 0xc, 0xf>(ninf, v));
    return v;
}
#define SWAP32(a, b) asm volatile("s_nop 1\n\tv_permlane32_swap_b32 %0, %1" : "+v"(a), "+v"(b))
#define SWAP16(a, b) asm volatile("s_nop 1\n\tv_permlane16_swap_b32 %0, %1" : "+v"(a), "+v"(b))
typedef float f32x2 __attribute__((ext_vector_type(2)));
__device__ __forceinline__ float sigmoidf_(float x) { return __builtin_amdgcn_rcpf(1.0f + __expf(-x)); }
__device__ __forceinline__ float logsigmoidf_(float x) { return fminf(x, 0.f) - log1pf(expf(-fabsf(x))); }

constexpr size_t al(size_t x) { return (x + 0xFFFFF) & ~(size_t)0xFFFFF; }
constexpr size_t WS_CTL = 0, CTL_ZERO_BYTES = 1u << 16, CTL_BYTES = 1u << 20;
constexpr size_t WS_MOD   = WS_CTL + CTL_BYTES;
constexpr size_t WS_ROPE  = WS_MOD + al((size_t)2 * 2 * 6144 * 4);
constexpr size_t WS_WGT   = WS_ROPE + al((size_t)256 * 16 * 2 * 4);
constexpr size_t WS_WRT   = WS_WGT + al((size_t)2 * 16 * 1024 * 4);
constexpr size_t WS_WIN   = WS_WRT + al((size_t)2 * 32 * 1024 * 4);
constexpr size_t WS_WV    = WS_WIN + al((size_t)2 * 2560 * 1024 * 2);
constexpr size_t WS_WOUT  = WS_WV + al((size_t)2 * 512 * 1024 * 2);
constexpr size_t WS_WGU   = WS_WOUT + al((size_t)2 * 1024 * 1024 * 2);
constexpr size_t WS_WDN   = WS_WGU + al((size_t)2 * 32 * 2048 * 1024 * 2);
constexpr size_t WS_X     = WS_WDN + al((size_t)2 * 32 * 1024 * 1024 * 2);
constexpr size_t WS_H     = WS_X + al((size_t)T * D * 4);
constexpr size_t WS_QB    = WS_H + al((size_t)T * D * 2);
constexpr size_t WS_KB    = WS_QB + al((size_t)8 * T * 64 * 2);
constexpr size_t WS_VT    = WS_KB + al((size_t)8 * T * 64 * 2);
constexpr size_t WS_MQ    = WS_VT + al((size_t)512 * T * 2);
constexpr size_t SEGB     = al((size_t)T * 256 * 4);
constexpr size_t WS_GATES = WS_MQ + 6 * SEGB;
constexpr size_t WS_BRE   = WS_GATES + al((size_t)T * 16 * 4);
constexpr size_t WS_BIM   = WS_BRE + al((size_t)SEQ * 256 * 4);
constexpr size_t WS_AOUT  = WS_BIM + al((size_t)SEQ * 256 * 4);
constexpr size_t WS_MIX   = WS_AOUT + al((size_t)T * D * 2);
constexpr size_t WS_CL    = WS_MIX + al((size_t)T * D * 4);
constexpr size_t WS_C0    = WS_CL + al((size_t)8 * NCH * 4160 * 4);
constexpr size_t WS_SCAL  = WS_C0 + al((size_t)8 * NCH * 4160 * 4);
constexpr size_t WS_F     = WS_SCAL + al((size_t)8 * NCH * 4 * 4);
constexpr size_t WS_TOKG  = WS_F + al((size_t)T * D * 2);
constexpr size_t WS_ELIST = WS_TOKG + al((size_t)T * 4 * 4);
constexpr size_t WS_SASG  = WS_ELIST + al((size_t)NE * T * 4);
constexpr size_t WS_SG    = WS_SASG + al((size_t)SLOT_ROWS * 4);
constexpr size_t WS_XG    = WS_SG + al((size_t)SLOT_ROWS * 4);
constexpr size_t WS_ACT   = WS_XG + al((size_t)SLOT_ROWS * D * 2);
constexpr size_t WS_YB    = WS_ACT + al((size_t)SLOT_ROWS * D * 2);
constexpr size_t WS_SROW  = WS_YB + al((size_t)SLOT_ROWS * D * 2);
constexpr size_t WS_TSLOT = WS_SROW + al((size_t)SLOT_ROWS * 4);
constexpr size_t WS_FTAB  = WS_TSLOT + al((size_t)T * 4 * 4);
constexpr size_t WS_END   = WS_FTAB + al((size_t)(2 * 64 * 64 + 2 * 128 * 128) * 2);
constexpr int CW_CNT = 64;
constexpr int CW_BAR = 8192;
constexpr int CW_KINF = 16;
constexpr int RING_BYTES = 131072, TAB_OFF = RING_BYTES, MISC_OFF = RING_BYTES + 2048, LDS_BYTES = 147456;

struct Args {
    const float* in[22]; float* out; unsigned char* ws; int ph_lo, ph_hi;
};
enum { I_X = 0, I_C, I_CTX, I_CCTX, I_WADA, I_BADA, I_WIN, I_GBIAS, I_DLAM, I_DNW, I_MNW, I_WOUT, I_LN1W, I_LN1B, I_WR, I_BR, I_WGU, I_BGU, I_WD, I_BD, I_LN2W, I_LN2B };
#define XB_TMO      128
#define XB_XCNT(j)  (256  + 64 * (j))
#define XB_XSUB(j)  (1280 + 64 * (j))
#define XB_XGEN(j)  (2304 + 64 * (j))
#define XB_TOP      3328
#define XB_TOPGEN   3392
#define XCD_BAR_WORDS 3456
#define XB_SPIN_CAP (1u << 18)

__device__ __forceinline__ unsigned xb_ld(unsigned* p)              { return __hip_atomic_load(p, __ATOMIC_RELAXED, __HIP_MEMORY_SCOPE_AGENT); }
__device__ __forceinline__ unsigned xb_add(unsigned* p, unsigned v) { return __hip_atomic_fetch_add(p, v, __ATOMIC_RELAXED, __HIP_MEMORY_SCOPE_AGENT); }
__device__ __forceinline__ unsigned xb_xcc_id() { return (unsigned)__builtin_amdgcn_s_getreg((3 << 11) | 20) & 0xFu; }
#define XB_SPIN(cond, bar) do { unsigned _sp = 0; while (cond) { __builtin_amdgcn_s_sleep(1); \
    if ((++_sp & 255u) == 0u) { if (xb_ld(&(bar)[XB_TMO])) break; if (_sp > XB_SPIN_CAP) { atomicAdd(&(bar)[XB_TMO], 1u); break; } } } } while (0)

struct XcdBarrier {
    unsigned* bar; unsigned x;
    volatile LAS unsigned* st;
};

__device__ __forceinline__ XcdBarrier xcd_barrier_post(unsigned* bar, volatile LAS unsigned* st) {
    XcdBarrier b; b.bar = bar; b.x = xb_xcc_id(); b.st = st;
    if (threadIdx.x == 0) (void)xb_add(&bar[XB_XCNT(b.x)], 1u);
    return b;
}
__device__ __forceinline__ void xcd_barrier_complete(unsigned* bar, unsigned x, unsigned& nloc, unsigned& nx) {
    const unsigned G = gridDim.x * gridDim.y * gridDim.z;
    unsigned sum, cnt, mine, sp = 0u;
    for (;;) {
        sum = 0u; cnt = 0u; mine = 0u;
#pragma unroll
        for (unsigned j = 0; j < 16; ++j) { const unsigned c = xb_ld(&bar[XB_XCNT(j)]); sum += c; cnt += (c > 0u) ? 1u : 0u; mine = (j == x) ? c : mine; }
        if (sum == G) break;
        __builtin_amdgcn_s_sleep(1);
        if ((++sp & 255u) == 0u) { if (xb_ld(&bar[XB_TMO])) break; if (sp > XB_SPIN_CAP) { atomicAdd(&bar[XB_TMO], 1u); break; } }
    }
    nloc = mine > 0u ? mine : 1u; nx = cnt > 0u ? cnt : 1u;
}

__device__ __forceinline__ void xcd_barrier(const XcdBarrier& b, const int tid) {
    asm volatile("s_waitcnt vmcnt(0)" ::: "memory");
    __syncthreads();
    if (tid == 0) {
        unsigned* bar = b.bar;
        __builtin_amdgcn_s_waitcnt(0);
        unsigned nloc = b.st[0], nx = b.st[1];
        if (nloc == 0u) { xcd_barrier_complete(bar, b.x, nloc, nx); b.st[0] = nloc; b.st[1] = nx; }
        const unsigned old = xb_add(&bar[XB_XSUB(b.x)], 1u);
        const unsigned gen = old / nloc;
        if (old + 1u == (gen + 1u) * nloc) {
            __builtin_amdgcn_fence(__ATOMIC_RELEASE, "agent");
            asm volatile("s_waitcnt vmcnt(0)" ::: "memory");
            const unsigned og = xb_add(&bar[XB_TOP], 1u);
            const unsigned tg = og / nx;
            if (og + 1u == (tg + 1u) * nx) xb_add(&bar[XB_TOPGEN], 1u);
            else XB_SPIN(xb_ld(&bar[XB_TOPGEN]) == tg, bar);
            __builtin_amdgcn_fence(__ATOMIC_ACQUIRE, "agent");
            xb_add(&bar[XB_XGEN(b.x)], 1u);
            asm volatile("s_waitcnt vmcnt(0)" ::: "memory");
        } else {
            XB_SPIN(xb_ld(&bar[XB_XGEN(b.x)]) == gen, bar);
            __builtin_amdgcn_fence(__ATOMIC_ACQUIRE, "agent");
            asm volatile("s_waitcnt vmcnt(0)" ::: "memory");
        }
    }
    __syncthreads();
}
namespace pg8 {
#define PG8_LAS __attribute__((address_space(3)))
typedef unsigned short bf16_t;
typedef short bf16x8 __attribute__((ext_vector_type(8)));
typedef float f32x4 __attribute__((ext_vector_type(4)));
typedef unsigned u32x4 __attribute__((ext_vector_type(4)));
constexpr int BM = 256, BK = 64, HALF = 128, HTB = HALF * BK * 2  , STAGE_BYTES = 8 * HTB, NXCD = 8, WGM = 8;

__host__ __device__ __forceinline__ int lds_byte(int r, int c) { const int st = (r >> 4) * 2 + (c >> 5), rr = r & 15, cc = c & 31, ob = rr * 64 + cc * 2; return st * 1024 + (ob ^ (((ob >> 9) & 1) << 5)); }
__host__ __device__ __forceinline__ void stage_rc(int b, int& R, int& C) { const int st = b / 1024, sb = b % 1024, swz = sb ^ (((sb >> 9) & 1) << 5); R = (st >> 1) * 16 + swz / 64; C = (st & 1) * 32 + (swz % 64) / 2; }
__host__ __device__ __forceinline__ int perm32(int rho) { const int n = rho >> 4, i = rho & 15; return 8 * (i >> 2) + 4 * n + (i & 3); }

struct Unit { int pm, pn, ty = 0; };
struct Gemm { const bf16_t* A; const bf16_t* Bt; int M, N, K; const int* gather = nullptr; const bf16_t* A2 = nullptr; const bf16_t* Bt2 = nullptr; };

struct StaticOrder {
    int nM, nN, nwg, G, c;
    __host__ __device__ void init(int M, int N, int G_, int c_) { nM = M / BM; nN = N / BM; nwg = nM * nN; G = G_; c = c_; }
    __host__ __device__ bool next(int i, Unit& u) const { const long L = (long)i * G + c; if (L >= nwg) return false; map((int)L, u); return true; }
    __host__ __device__ bool map(int L, Unit& u) const {
        int wgid = L; { const int q = nwg / NXCD, r = nwg % NXCD, xcd = wgid % NXCD, off = wgid / NXCD; wgid = (xcd < r ? xcd * (q + 1) : r * (q + 1) + (xcd - r) * q) + off; }
        const int nig = WGM * nN, gid = wgid / nig, fm = gid * WGM, gsz = (nM - fm) < WGM ? (nM - fm) : WGM;
        u.pm = fm + ((wgid % nig) % gsz); u.pn = (wgid % nig) / gsz; return true;
    }
    __device__ __forceinline__ void a_ready(const Unit&) const {}
    __device__ __forceinline__ void done(const Unit&) const {}
};

__device__ __forceinline__ unsigned cvt_pk_bf16(float lo, float hi) { unsigned r; asm volatile("v_cvt_pk_bf16_f32 %0, %1, %2" : "=v"(r) : "v"(lo), "v"(hi)); return r; }
typedef float f32x2 __attribute__((ext_vector_type(2)));
template <class Epi, class Sched, bool ALIGN_EPI = false, bool SP2 = false, bool GATHER = false>
__device__ __forceinline__ void gemm_phase(PG8_LAS unsigned char* lds, const Gemm g, const Sched& S, const Epi& E, const int tid_in) {
    const int tid = tid_in, wid = __builtin_amdgcn_readfirstlane(tid >> 6), lane = tid & 63, wr = wid >> 2, wc = wid & 3, fr = lane & 15, fq = lane >> 4;
    const int K = g.K, nt = K / BK;
    unsigned voffA[2], voffB[2];
    int gR[2], gC[2];
#pragma unroll
    for (int i = 0; i < 2; ++i) { int R, C; stage_rc(tid * 16 + i * 8192, R, C); const int Rb = Epi::PERM ? ((R & ~31) + perm32(R & 31)) : R; gR[i] = R; gC[i] = C;
        voffA[i] = (unsigned)(R * K + C) * 2u; voffB[i] = (unsigned)(Rb * K + C) * 2u; }
    unsigned offC[2][2], offN[2][2];
#define PG8_GOFF(dst, u) do { _Pragma("unroll") for (int h_ = 0; h_ < 2; ++h_) _Pragma("unroll") for (int i_ = 0; i_ < 2; ++i_) \
        (dst)[h_][i_] = (unsigned)g.gather[(u).pm * BM + h_ * HALF + gR[i_]] * (unsigned)(K * 2) + (unsigned)gC[i_] * 2u; } while (0)
    const size_t kstep = (size_t)(BK * 2);
    const size_t hstep = (size_t)HALF * K * 2;
    const size_t tstep = 2 * hstep;
    const unsigned ldsw = (unsigned)wid * 1024u;
    const int aoff = lds_byte(wr * 64 + fr, fq * 8), boff = lds_byte(wc * 32 + fr, fq * 8);
#define PG8_SA(b, h) (((b) * 2 + (h)) * HTB)
#define PG8_SB(b, h) ((4 + (b) * 2 + (h)) * HTB)
#define PG8_STAGE(bufoff, gbase, voff) do { _Pragma("unroll") for (int _i = 0; _i < 2; ++_i) \
        __builtin_amdgcn_global_load_lds((const unsigned*)((const char*)(gbase) + (voff)[_i]), (PG8_LAS unsigned*)(lds + (bufoff) + ldsw + _i * 8192), 16, 0, 0); } while (0)
#define PG8_LDA(dst, b, h) do { _Pragma("unroll") for (int m = 0; m < 4; ++m) _Pragma("unroll") for (int k = 0; k < 2; ++k) dst[m][k] = *(const PG8_LAS bf16x8*)(lds + PG8_SA(b, h) + aoff + m * 2048 + k * 1024); } while (0)
#define PG8_LDB(dst, b, h) do { _Pragma("unroll") for (int n = 0; n < 2; ++n) _Pragma("unroll") for (int k = 0; k < 2; ++k) dst[n][k] = *(const PG8_LAS bf16x8*)(lds + PG8_SB(b, h) + boff + n * 2048 + k * 1024); } while (0)
#define PG8_MMA(ai, bj, At, Bt) do { __builtin_amdgcn_s_setprio(1); _Pragma("unroll") for (int m = 0; m < 4; ++m) _Pragma("unroll") for (int n = 0; n < 2; ++n) _Pragma("unroll") for (int k = 0; k < 2; ++k) \
        acc[ai][bj][m][n] = __builtin_amdgcn_mfma_f32_16x16x32_bf16(Bt[n][k], At[m][k], acc[ai][bj][m][n], 0, 0, 0); __builtin_amdgcn_s_setprio(0); } while (0)
#define PG8_WAIT_V(n) asm volatile("s_waitcnt vmcnt(" #n ")" ::: "memory")
#define PG8_WAIT_L(n) asm volatile("s_waitcnt lgkmcnt(" #n ")" ::: "memory")
#define PG8_BAR __builtin_amdgcn_s_barrier()
#define PG8_SCHED __builtin_amdgcn_sched_barrier(0)
    Unit cur, nxt; int ui = 0;
    if (!S.next(0, cur)) return;
    f32x4 acc[2][2][4][2];
#pragma unroll
    for (int a = 0; a < 2; ++a)
#pragma unroll
        for (int b = 0; b < 2; ++b)
#pragma unroll
            for (int m = 0; m < 4; ++m)
#pragma unroll
                for (int n = 0; n < 2; ++n) acc[a][b][m][n] = (f32x4){0.f, 0.f, 0.f, 0.f};
    bf16x8 At[4][2], B0[2][2], B1[2][2];
    const char* cA = GATHER ? (const char*)g.A : (const char*)(cur.ty ? g.A2 : g.A) + (size_t)cur.pm * tstep; const char* cB = (const char*)(cur.ty ? g.Bt2 : g.Bt) + (size_t)cur.pn * tstep;
    if constexpr (GATHER) PG8_GOFF(offC, cur);
    S.a_ready(cur);
#define PG8_OA(h) (GATHER ? offC[h] : voffA)
#define PG8_HS(h) (GATHER ? (size_t)0 : (size_t)(h) * hstep)
    if constexpr (SP2) {
        PG8_STAGE(PG8_SB(0, 0), cB, voffB); PG8_STAGE(PG8_SB(0, 1), cB + hstep, voffB); PG8_STAGE(PG8_SA(0, 0), cA, PG8_OA(0)); PG8_STAGE(PG8_SA(0, 1), cA + PG8_HS(1), PG8_OA(1));
        if (wr == 1) PG8_BAR;
        PG8_WAIT_V(2); PG8_BAR;
        PG8_STAGE(PG8_SB(1, 0), cB + kstep, voffB); PG8_STAGE(PG8_SA(1, 0), cA + kstep, PG8_OA(0)); PG8_STAGE(PG8_SB(1, 1), cB + hstep + kstep, voffB);
        PG8_WAIT_V(6); PG8_BAR;
    } else {
        PG8_STAGE(PG8_SB(0, 0), cB, voffB); PG8_STAGE(PG8_SA(0, 0), cA, voffA); PG8_STAGE(PG8_SB(0, 1), cB + hstep, voffB); PG8_STAGE(PG8_SA(0, 1), cA + hstep, voffA);
        if (wr == 1) PG8_BAR;
        PG8_WAIT_V(4); PG8_BAR;
        PG8_STAGE(PG8_SB(1, 0), cB + kstep, voffB); PG8_STAGE(PG8_SA(1, 0), cA + kstep, voffA); PG8_STAGE(PG8_SB(1, 1), cB + hstep + kstep, voffB);
        PG8_WAIT_V(6); PG8_BAR;
    }
    for (;;) {
        const bool has_next = S.next(ui + 1, nxt);
        const char* nA = GATHER ? cA : (has_next ? (const char*)(nxt.ty ? g.A2 : g.A) + (size_t)nxt.pm * tstep : cA); const char* nB = has_next ? (const char*)(nxt.ty ? g.Bt2 : g.Bt) + (size_t)nxt.pn * tstep : cB;
        if constexpr (GATHER) { if (has_next) PG8_GOFF(offN, nxt); else {
#pragma unroll
            for (int h_ = 0; h_ < 2; ++h_)
#pragma unroll
                for (int i_ = 0; i_ < 2; ++i_) offN[h_][i_] = offC[h_][i_]; } }
        for (int t = 0; t < nt; t += 2) {
            const bool last = (t == nt - 2);
            const char* a1 = cA + (size_t)(t + 1) * kstep;
            const char* a2 = last ? nA : cA + (size_t)(t + 2) * kstep; const char* b2 = last ? nB : cB + (size_t)(t + 2) * kstep;
            unsigned oN0[2], oN1[2];
#pragma unroll
            for (int i_ = 0; i_ < 2; ++i_) { if constexpr (GATHER) { oN0[i_] = last ? offN[0][i_] : offC[0][i_]; oN1[i_] = last ? offN[1][i_] : offC[1][i_]; } else { oN0[i_] = voffA[i_]; oN1[i_] = voffA[i_]; } }
            const char* a3 = a2 + kstep; const char* b3 = b2 + kstep;
            if (last && has_next) S.a_ready(nxt);
            if constexpr (SP2) {
            PG8_LDB(B0, 0, 0); PG8_LDB(B1, 0, 1); PG8_SCHED; PG8_LDA(At, 0, 0); PG8_STAGE(PG8_SA(1, 1), a1 + PG8_HS(1), PG8_OA(1));
            PG8_WAIT_V(8); PG8_WAIT_L(0); PG8_BAR; PG8_MMA(0, 0, At, B0); PG8_MMA(0, 1, At, B1); PG8_BAR; PG8_SCHED;
            PG8_LDA(At, 0, 1); PG8_STAGE(PG8_SB(0, 0), b2, voffB); PG8_STAGE(PG8_SB(0, 1), b2 + hstep, voffB); PG8_STAGE(PG8_SA(0, 0), a2, oN0);
            PG8_WAIT_V(8); PG8_WAIT_L(0); PG8_BAR; PG8_MMA(1, 0, At, B0); PG8_MMA(1, 1, At, B1); PG8_BAR; PG8_SCHED;
            PG8_LDB(B0, 1, 0); PG8_LDB(B1, 1, 1); PG8_SCHED; PG8_LDA(At, 1, 0); PG8_STAGE(PG8_SA(0, 1), a2 + PG8_HS(1), oN1);
            PG8_WAIT_V(8); PG8_WAIT_L(0); PG8_BAR; PG8_MMA(0, 0, At, B0); PG8_MMA(0, 1, At, B1); PG8_BAR; PG8_SCHED;
            PG8_LDA(At, 1, 1); PG8_STAGE(PG8_SB(1, 0), b3, voffB); PG8_STAGE(PG8_SB(1, 1), b3 + hstep, voffB); PG8_STAGE(PG8_SA(1, 0), a3, oN0);
            PG8_WAIT_V(8); PG8_WAIT_L(0); PG8_BAR; PG8_MMA(1, 0, At, B0); PG8_MMA(1, 1, At, B1); PG8_BAR; PG8_SCHED;
            } else {
            PG8_LDB(B0, 0, 0); PG8_SCHED; PG8_LDA(At, 0, 0); PG8_STAGE(PG8_SA(1, 1), a1 + hstep, voffA);
            PG8_WAIT_L(8); PG8_BAR; PG8_WAIT_L(0); PG8_MMA(0, 0, At, B0); PG8_BAR; PG8_SCHED;
            PG8_LDB(B1, 0, 1); PG8_STAGE(PG8_SB(0, 0), b2, voffB);
            PG8_BAR; PG8_WAIT_L(0); PG8_MMA(0, 1, At, B1); PG8_BAR;
            PG8_LDA(At, 0, 1); PG8_STAGE(PG8_SA(0, 0), a2, voffA);
            PG8_BAR; PG8_WAIT_L(0); PG8_MMA(1, 0, At, B0); PG8_BAR; PG8_SCHED;
            PG8_STAGE(PG8_SB(0, 1), b2 + hstep, voffB);
            PG8_WAIT_V(6); PG8_BAR; PG8_MMA(1, 1, At, B1); PG8_BAR;
            PG8_LDB(B0, 1, 0); PG8_SCHED; PG8_LDA(At, 1, 0); PG8_STAGE(PG8_SA(0, 1), a2 + hstep, voffA);
            PG8_WAIT_L(8); PG8_BAR; PG8_WAIT_L(0); PG8_MMA(0, 0, At, B0); PG8_BAR; PG8_SCHED;
            PG8_LDB(B1, 1, 1); PG8_STAGE(PG8_SB(1, 0), b3, voffB);
            PG8_BAR; PG8_WAIT_L(0); PG8_MMA(0, 1, At, B1); PG8_BAR;
            PG8_LDA(At, 1, 1); PG8_STAGE(PG8_SA(1, 0), a3, voffA);
            PG8_BAR; PG8_WAIT_L(0); PG8_MMA(1, 0, At, B0); PG8_BAR; PG8_SCHED;
            PG8_STAGE(PG8_SB(1, 1), b3 + hstep, voffB);
            PG8_WAIT_V(6); PG8_BAR; PG8_MMA(1, 1, At, B1); PG8_BAR;
            }
        }
        if constexpr (ALIGN_EPI) { if (wr == 0) PG8_BAR; }
        if constexpr (!Epi::AFTER_DRAIN) { E(acc, cur, wr, wc, fr, fq); S.done(cur); }
        if (!has_next) break;
#pragma unroll
        for (int a = 0; a < 2; ++a)
#pragma unroll
            for (int b = 0; b < 2; ++b)
#pragma unroll
                for (int m = 0; m < 4; ++m)
#pragma unroll
                    for (int n = 0; n < 2; ++n) acc[a][b][m][n] = (f32x4){0.f, 0.f, 0.f, 0.f};
        cur = nxt; cA = nA; cB = nB; ++ui;
        if constexpr (GATHER) {
#pragma unroll
            for (int h_ = 0; h_ < 2; ++h_)
#pragma unroll
                for (int i_ = 0; i_ < 2; ++i_) offC[h_][i_] = offN[h_][i_]; }
        if constexpr (ALIGN_EPI) { if (wr == 1) PG8_BAR; }
    }
    PG8_WAIT_V(0);
    if constexpr (!ALIGN_EPI) { if (wr == 0) PG8_BAR; }
    PG8_BAR;
    if constexpr (Epi::AFTER_DRAIN) { E.fused(acc, cur, wr, wc, fr, fq, lds, wid, lane); S.done(cur); }
#undef PG8_SA
#undef PG8_OA
#undef PG8_HS
#undef PG8_GOFF
#undef PG8_SB
#undef PG8_STAGE
#undef PG8_LDA
#undef PG8_LDB
#undef PG8_MMA
#undef PG8_WAIT_V
#undef PG8_WAIT_L
#undef PG8_BAR
#undef PG8_SCHED
}
}

namespace pg8 {
__device__ __forceinline__ void st_pair16(bf16_t* p0, unsigned a0, unsigned a1, unsigned b0, unsigned b1, int fq) {
    SWAP16(a0, b0); SWAP16(a1, b1);
    *(v4u*)(p0 + ((fq & 1) ? 12 : 0)) = (v4u){a0, a1, b0, b1};
}
__device__ __forceinline__ void st_pair16b(unsigned char* p0, unsigned char* p1, unsigned a0, unsigned a1, unsigned b0, unsigned b1, int fq) {
    SWAP16(a0, b0); SWAP16(a1, b1);
    *(v4u*)((fq & 1) ? p1 - 8 : p0) = (v4u){a0, a1, b0, b1};
}
struct EpiInProj {
    static constexpr bool PERM = false, AFTER_DRAIN = false;
    bf16_t* QB; bf16_t* KB; float* SEG; const float* rope; unsigned* kinf;
    __device__ __forceinline__ void operator()(const f32x4 (&acc)[2][2][4][2], const Unit& u, int wr, int wc, int fr, int fq) const {
        const int pn = u.pn;
        if (pn < 4) {
            const bool isq = pn < 2; unsigned char* dst = (unsigned char*)(isq ? QB : KB); const float sc = isq ? QSCALE * 4.0f : 0.25f;
            const int axis = wc & 1;
            float amax0 = 0.f, amax1 = 0.f;
            f32x4 na = {1.f, 0.f, 1.f, 0.f}, nb = {1.f, 0.f, 1.f, 0.f};
#define EIP_ROPE(ai_, m_) do { const int row_ = u.pm * BM + (ai_) * HALF + wr * 64 + (m_) * 16 + fr; \
                if (row_ >= NCTX) { const int n_ = row_ - NCTX; const int pos_ = axis ? (n_ & 63) : (n_ >> 6); const f32x4* rp_ = (const f32x4*)(rope + (size_t)(pos_ * 16 + 4 * fq) * 2); na = rp_[0]; nb = rp_[1]; } \
                else { na = (f32x4){1.f, 0.f, 1.f, 0.f}; nb = na; } } while (0)
            EIP_ROPE(0, 0);
#pragma unroll
            for (int ai = 0; ai < 2; ++ai)
#pragma unroll
                for (int m = 0; m < 4; ++m) {
                    const int row = u.pm * BM + ai * HALF + wr * 64 + m * 16 + fr;
                    asm volatile("" ::: "memory");
                    const f32x4 a = na, b = nb;
                    if (ai * 4 + m < 7) EIP_ROPE((ai * 4 + m + 1) >> 2, (ai * 4 + m + 1) & 3);
                    const f32x4 cs0 = {a[0], a[2], b[0], b[2]}, sn0 = {a[1], a[3], b[1], b[3]};
                    unsigned qw[2][2]; unsigned char* qp[2];
#pragma unroll
                    for (int bj = 0; bj < 2; ++bj) {
                        const int cc = (pn & 1) * 256 + bj * HALF + wc * 32;
                        const int map = cc >> 6;
                        const f32x4 x0 = acc[ai][bj][m][0], x1 = acc[ai][bj][m][1];
                        const f32x4 o0 = (x0 * cs0 - x1 * sn0) * sc, o1 = (x1 * cs0 + x0 * sn0) * sc;
                        qp[bj] = dst + ((size_t)map * T + row) * 64 + (cc & 63) + 8 * fq;
                        int w0 = __builtin_amdgcn_cvt_pk_fp8_f32(o0[0], o0[1], 0, false); w0 = __builtin_amdgcn_cvt_pk_fp8_f32(o0[2], o0[3], w0, true);
                        int w1 = __builtin_amdgcn_cvt_pk_fp8_f32(o1[0], o1[1], 0, false); w1 = __builtin_amdgcn_cvt_pk_fp8_f32(o1[2], o1[3], w1, true);
                        qw[bj][0] = (unsigned)w0; qw[bj][1] = (unsigned)w1;
                        if (!isq) { float a = (o0[0] * o0[0] + o0[1] * o0[1]) + (o0[2] * o0[2] + o0[3] * o0[3]) + (o1[0] * o1[0] + o1[1] * o1[1]) + (o1[2] * o1[2] + o1[3] * o1[3]);
                            if (bj == 0) amax0 = fmaxf(amax0, a); else amax1 = fmaxf(amax1, a); }
                    }
                    st_pair16b(qp[0], qp[1], qw[0][0], qw[0][1], qw[1][0], qw[1][1], fq);
                }
#undef EIP_ROPE
            if (!isq) {
                amax0 = wave_max(amax0, fr + 16 * fq); amax1 = wave_max(amax1, fr + 16 * fq);
                if (fr == 0 && fq == 0) { const int map0 = ((pn & 1) * 256 + wc * 32) >> 6;
                    atomicMax(kinf + map0 * 2 + axis, __float_as_uint(4.0f * amax0)); atomicMax(kinf + (map0 + 2) * 2 + axis, __float_as_uint(4.0f * amax1)); }
            }
        } else {
            const int seg = pn - 4; bf16_t* dst = (bf16_t*)((char*)SEG + (size_t)seg * SEGB); const float sc = (seg == 1) ? 0.125f : 1.0f;
#pragma unroll
            for (int ai = 0; ai < 2; ++ai)
#pragma unroll
                for (int m = 0; m < 4; ++m) {
                    const int row = u.pm * BM + ai * HALF + wr * 64 + m * 16 + fr;
                    asm volatile("" ::: "memory");
                    bf16_t* rowp = dst + (size_t)row * 256 + wc * 32 + 4 * fq;
#pragma unroll
                    for (int bj = 0; bj < 2; ++bj)
                        { const f32x4 v = acc[ai][bj][m][0] * sc, x = acc[ai][bj][m][1] * sc; st_pair16(rowp + bj * HALF, pk2(v[0], v[1]), pk2(v[2], v[3]), pk2(x[0], x[1]), pk2(x[2], x[3]), fq); }
                }
        }
    }
};
struct EpiVt {
    static constexpr bool PERM = false, AFTER_DRAIN = false;
    bf16_t* VT; unsigned char* VT8;
    __device__ __forceinline__ void operator()(const f32x4 (&acc)[2][2][4][2], const Unit& u, int wr, int wc, int fr, int fq) const {
#pragma unroll
        for (int ai = 0; ai < 2; ++ai)
#pragma unroll
            for (int m = 0; m < 4; ++m) {
                const int row = u.pm * BM + ai * HALF + wr * 64 + m * 16 + fr;
                asm volatile("" ::: "memory");
                bf16_t* rowp = VT + (size_t)row * T + u.pn * BM + wc * 32 + 4 * fq;
#pragma unroll
                for (int bj = 0; bj < 2; ++bj)
                    { const f32x4 v = acc[ai][bj][m][0], x = acc[ai][bj][m][1]; st_pair16(rowp + bj * HALF, pk2(v[0], v[1]), pk2(v[2], v[3]), pk2(x[0], x[1]), pk2(x[2], x[3]), fq);
                      int a8 = __builtin_amdgcn_cvt_pk_fp8_f32(v[0] * 4.0f, v[1] * 4.0f, 0, false); a8 = __builtin_amdgcn_cvt_pk_fp8_f32(v[2] * 4.0f, v[3] * 4.0f, a8, true);
                      int b8 = __builtin_amdgcn_cvt_pk_fp8_f32(x[0] * 4.0f, x[1] * 4.0f, 0, false); b8 = __builtin_amdgcn_cvt_pk_fp8_f32(x[2] * 4.0f, x[3] * 4.0f, b8, true);
                      unsigned ua = (unsigned)a8, ub = (unsigned)b8; SWAP16(ua, ub);
                      const int tok8 = u.pn * BM + bj * HALF + wc * 32 + ((fq & 1) ? 16 + 4 * (fq - 1) : 4 * fq), g8 = (tok8 & 63) >> 3;
                      *(v2u*)(VT8 + (size_t)row * T + (tok8 & ~63) + 32 * (g8 & 1) + 8 * (g8 >> 1)) = (v2u){ua, ub}; }
            }
    }
};
struct EpiBf16Plain {
    static constexpr bool PERM = false, AFTER_DRAIN = false;
    bf16_t* C; int ldc;
    __device__ __forceinline__ void operator()(const f32x4 (&acc)[2][2][4][2], const Unit& u, int wr, int wc, int fr, int fq) const {
        const int row0 = u.pm * BM + wr * 64 + fr, col0 = u.pn * BM + wc * 32 + 4 * fq;
#pragma unroll
        for (int ai = 0; ai < 2; ++ai)
#pragma unroll
            for (int m = 0; m < 4; ++m) { asm volatile("" ::: "memory"); bf16_t* rowp = C + (size_t)(row0 + ai * HALF + m * 16) * ldc + col0;
#pragma unroll
                for (int bj = 0; bj < 2; ++bj)
                    { const f32x4 v = acc[ai][bj][m][0], x = acc[ai][bj][m][1]; st_pair16(rowp + bj * HALF, pk2(v[0], v[1]), pk2(v[2], v[3]), pk2(x[0], x[1]), pk2(x[2], x[3]), fq); } }
    }
};
struct EpiNull {
    static constexpr bool PERM = false, AFTER_DRAIN = false;
    float* sink;
    __device__ __forceinline__ void operator()(const f32x4 (&acc)[2][2][4][2], const Unit& u, int wr, int wc, int fr, int fq) const {
        f32x4 s = {0.f, 0.f, 0.f, 0.f};
#pragma unroll
        for (int ai = 0; ai < 2; ++ai)
#pragma unroll
            for (int bj = 0; bj < 2; ++bj)
#pragma unroll
                for (int m = 0; m < 4; ++m)
#pragma unroll
                    for (int n = 0; n < 2; ++n) s += acc[ai][bj][m][n];
        if (s[0] == 1.2345e30f) *(f32x4*)sink = s;
    }
};
struct EpiF32 {
    static constexpr bool PERM = false, AFTER_DRAIN = false;
    float* C; int ldc;
    __device__ __forceinline__ void operator()(const f32x4 (&acc)[2][2][4][2], const Unit& u, int wr, int wc, int fr, int fq) const {
        const int row0 = u.pm * BM + wr * 64 + fr, col0 = u.pn * BM + wc * 32 + 4 * fq;
#pragma unroll
        for (int ai = 0; ai < 2; ++ai)
#pragma unroll
            for (int m = 0; m < 4; ++m) { asm volatile("" ::: "memory"); float* rowp = C + (size_t)(row0 + ai * HALF + m * 16) * ldc + col0;
#pragma unroll
                for (int bj = 0; bj < 2; ++bj)
#pragma unroll
                    for (int n = 0; n < 2; ++n) *(f32x4*)(rowp + bj * HALF + n * 16) = acc[ai][bj][m][n]; }
    }
};
struct EpiSwiglu {
    static constexpr bool PERM = false, AFTER_DRAIN = false;
    bf16_t* ACT; const float* bgu;
    __device__ __forceinline__ void operator()(const f32x4 (&acc)[2][2][4][2], const Unit& u, int wr, int wc, int fr, int fq) const {
        const int e = u.pn >> 3, pnl = u.pn & 7;
        const float* bg = bgu + (size_t)e * 2048;
        f32x4 bgv[2], buv[2];
#pragma unroll
        for (int bj = 0; bj < 2; ++bj) { const int d = pnl * 128 + bj * 64 + wc * 16 + 4 * fq; bgv[bj] = *(const f32x4*)(bg + d); buv[bj] = *(const f32x4*)(bg + 1024 + d) + 1.0f; }
#pragma unroll
        for (int ai = 0; ai < 2; ++ai)
#pragma unroll
            for (int m = 0; m < 4; ++m) {
                const int row = u.pm * BM + ai * HALF + wr * 64 + m * 16 + fr;
                asm volatile("" ::: "memory");
                unsigned sw[2][2];
#pragma unroll
                for (int bj = 0; bj < 2; ++bj) {
                    const f32x4 g4 = acc[ai][bj][m][0] + bgv[bj], u4 = acc[ai][bj][m][1] + buv[bj];
                    float o[4];
#pragma unroll
                    for (int i = 0; i < 4; ++i) { const float g = fminf(g4[i], 7.0f); const float up1 = fminf(fmaxf(u4[i], -6.0f), 8.0f);
                        o[i] = g * __builtin_amdgcn_rcpf(1.0f + __builtin_amdgcn_exp2f(-1.702f * 1.44269504089f * g)) * up1; }
                    sw[bj][0] = pk2(o[0], o[1]); sw[bj][1] = pk2(o[2], o[3]);
                }
                { unsigned char* pa = (unsigned char*)(ACT + (size_t)row * D + pnl * 128 + wc * 16 + 4 * fq);
                  st_pair16b(pa, pa + 128, sw[0][0], sw[0][1], sw[1][0], sw[1][1], fq); }
            }
    }
};
struct EpiDown {
    static constexpr bool PERM = false, AFTER_DRAIN = false;
    bf16_t* YB; const float* bd; const float* sg;
    __device__ __forceinline__ void operator()(const f32x4 (&acc)[2][2][4][2], const Unit& u, int wr, int wc, int fr, int fq) const {
        const int e = u.pn >> 2, pnl = u.pn & 3;
        const int col0 = pnl * 256 + wc * 32 + 4 * fq;
        f32x4 bv[2][2];
#pragma unroll
        for (int bj = 0; bj < 2; ++bj)
#pragma unroll
            for (int n = 0; n < 2; ++n) bv[bj][n] = *(const f32x4*)(bd + (size_t)e * D + col0 + bj * HALF + n * 16);
        float gwv[2][4];
#pragma unroll
        for (int ai = 0; ai < 2; ++ai)
#pragma unroll
            for (int m = 0; m < 4; ++m) gwv[ai][m] = sg[u.pm * BM + ai * HALF + wr * 64 + m * 16 + fr];
#pragma unroll
        for (int ai = 0; ai < 2; ++ai)
#pragma unroll
            for (int m = 0; m < 4; ++m) {
                const int row = u.pm * BM + ai * HALF + wr * 64 + m * 16 + fr;
                asm volatile("" ::: "memory");
                const float gw = gwv[ai][m];
                bf16_t* rowp = YB + (size_t)row * D + col0;
#pragma unroll
                for (int bj = 0; bj < 2; ++bj)
                    { const f32x4 v = (acc[ai][bj][m][0] + bv[bj][0]) * gw, x = (acc[ai][bj][m][1] + bv[bj][1]) * gw; st_pair16(rowp + bj * HALF, pk2(v[0], v[1]), pk2(v[2], v[3]), pk2(x[0], x[1]), pk2(x[2], x[3]), fq); }
            }
    }
};
struct InProjOrder {
    StaticOrder s1, s2; int G, c;
    __device__ __forceinline__ bool next(int i, Unit& u) const {
        const int L = i * G + c;
        if (L < s1.nwg) { s1.map(L, u); u.ty = 0; return true; }
        if (L < s1.nwg + s2.nwg) { s2.map(L - s1.nwg, u); u.ty = 1; return true; }
        return false;
    }
    __device__ __forceinline__ void a_ready(const Unit&) const {}
    __device__ __forceinline__ void done(const Unit&) const {}
};
struct EpiInProjAll {
    static constexpr bool PERM = false, AFTER_DRAIN = false;
    EpiInProj e1; EpiVt e2;
    __device__ __forceinline__ void operator()(const f32x4 (&acc)[2][2][4][2], const Unit& u, int wr, int wc, int fr, int fq) const { if (u.ty) e2(acc, u, wr, wc, fr, fq); else e1(acc, u, wr, wc, fr, fq); }
};
struct MoeOrder {
    const volatile PG8_LAS int* up; const volatile PG8_LAS int* mt; const volatile PG8_LAS int* bt; int npn, G, c;
    __device__ __forceinline__ bool next(int i, Unit& u) const {
        const int total = up[32], ch = (total + 7) >> 3, ix = i * (G >> 3) + (c >> 3);
        const int L = (c & 7) * ch + ix;
        if (ix >= ch || L >= total) return false;
        int e = 0;
#pragma unroll 1
        for (int j = 1; j < 32; ++j) e += (L >= up[j]) ? 1 : 0;
        const int idx = L - up[e], m = mt[e];
        u.pm = bt[e] + idx % m; u.pn = e * npn + idx / m; return true;
    }
    __device__ __forceinline__ void a_ready(const Unit&) const {}
    __device__ __forceinline__ void done(const Unit&) const {}
};
struct ListOrder {
    const volatile PG8_LAS int* lst;
    __device__ __forceinline__ bool next(int i, Unit& u) const { if (i >= 16) return false; const int pm = lst[4 * i]; if (pm < 0) return false; u.pm = pm; u.pn = lst[4 * i + 1]; u.ty = lst[4 * i + 2]; return true; }
    __device__ __forceinline__ void a_ready(const Unit&) const {}
    __device__ __forceinline__ void done(const Unit&) const {}
};
}

struct Frame {
    LAS unsigned char* lds;
    volatile LAS int* MISC;
    int tid, lane, wave, G, bid;
    unsigned char* ws;
    const float* const* in;
    float* out;
};
#define WSP(type, off) ((type*)(F.ws + (off)))

struct TItem { const float* src; bf16* dst; int ldw; };
__device__ __forceinline__ TItem titem_decode(Frame& F, int it, int c4) {
    constexpr int I_A = 16 * 72, I_V = 16 * 16, I_O = 16 * 32, I_GU = 16 * 64, I_DN = 16 * 32;
    constexpr int PER_L = I_A + I_V + I_O + NE * I_GU + NE * I_DN;
    const int l = it / PER_L; int r = it % PER_L; TItem t;
    const float* win = F.in[I_WIN] + (size_t)l * D * INW;
    if (r < I_A) { const int k0 = (r / 72) * 64, n = (r % 72) * 32 + 4 * c4; const int sc = n < 1024 ? n : (n < 2048 ? n + 512 : n + 528);
        t.src = win + (size_t)k0 * INW + sc; t.dst = WSP(bf16, WS_WIN) + ((size_t)l * 2560 + (r % 72) * 32) * D + k0; t.ldw = INW; return t; } r -= I_A;
    if (r < I_V) { const int k0 = (r / 16) * 64, n0 = (r % 16) * 32; t.src = win + (size_t)k0 * INW + 1024 + n0 + 4 * c4; t.dst = WSP(bf16, WS_WV) + ((size_t)l * 512 + n0) * D + k0; t.ldw = INW; return t; } r -= I_V;
    if (r < I_O) { const int k0 = (r / 32) * 64, n0 = (r % 32) * 32; t.src = F.in[I_WOUT] + (size_t)l * D * D + (size_t)k0 * D + n0 + 4 * c4; t.dst = WSP(bf16, WS_WOUT) + ((size_t)l * D + n0) * D + k0; t.ldw = D; return t; } r -= I_O;
    if (r < NE * I_GU) { const int e = r / I_GU, q = r % I_GU, k0 = (q / 64) * 64, n0 = (q % 64) * 32, n = n0 + 4 * c4; const int d = (n >> 5) * 16 + (n & 15); const int sc = ((n >> 4) & 1) ? 1024 + d : d;
        t.src = F.in[I_WGU] + ((size_t)l * NE + e) * D * 2048 + (size_t)k0 * 2048 + sc; t.dst = WSP(bf16, WS_WGU) + (((size_t)l * NE + e) * 2048 + n0) * D + k0; t.ldw = 2048; return t; } r -= NE * I_GU;
    { const int e = r / I_DN, q = r % I_DN, k0 = (q / 32) * 64, n0 = (q % 32) * 32;
      t.src = F.in[I_WD] + ((size_t)l * NE + e) * D * D + (size_t)k0 * D + n0 + 4 * c4; t.dst = WSP(bf16, WS_WDN) + (((size_t)l * NE + e) * D + n0) * D + k0; t.ldw = D; return t; }
}
__device__ __forceinline__ void titem_load(const TItem& t, int lane, f32x4 (&v)[8]) {
#pragma unroll
    for (int q = 0; q < 8; ++q) v[q] = *(const f32x4*)(t.src + (size_t)(8 * (lane & 7) + q) * t.ldw);
}
__device__ __forceinline__ void titem_store(const TItem& t, const f32x4 (&v)[8], int lane) {
#pragma unroll
    for (int e = 0; e < 4; ++e) {
        v4u o; o.x = pk2(v[0][e], v[1][e]); o.y = pk2(v[2][e], v[3][e]); o.z = pk2(v[4][e], v[5][e]); o.w = pk2(v[6][e], v[7][e]);
        *(v4u*)(t.dst + (size_t)(4 * (lane >> 3) + e) * D + 8 * (lane & 7)) = o; }
}

__device__ __forceinline__ void p0_prologue(Frame& F) {
    const float* w_ada = F.in[I_WADA]; const float* b_ada = F.in[I_BADA]; const float* cvec = F.in[I_C]; const float* cctx = F.in[I_CCTX];
    {
        LAS float* red = (LAS float*)F.lds;
        for (int it = F.bid; it < 192; it += F.G) {
            const int l = it / 96, col = (it % 96) * 64 + F.lane;
            const float* W = w_ada + (size_t)l * D * 6144;
            float a0 = 0.f, a1 = 0.f;
            const float c0a = cvec[F.wave * 128 + F.lane], c0b = cvec[F.wave * 128 + 64 + F.lane], c1a = cctx[F.wave * 128 + F.lane], c1b = cctx[F.wave * 128 + 64 + F.lane];
            const float s0a = c0a * sigmoidf_(c0a), s0b = c0b * sigmoidf_(c0b), s1a = c1a * sigmoidf_(c1a), s1b = c1b * sigmoidf_(c1b);
#pragma unroll 1
            for (int kk = 0; kk < 128; kk += 16) {
                float w[16];
#pragma unroll
                for (int j = 0; j < 16; ++j) w[j] = W[(size_t)(F.wave * 128 + kk + j) * 6144 + col];
                const float s0 = kk < 64 ? s0a : s0b, s1 = kk < 64 ? s1a : s1b;
#pragma unroll
                for (int j = 0; j < 16; ++j) { const int ln = (kk + j) & 63;
                    a0 += __builtin_bit_cast(float, __builtin_amdgcn_readlane(__builtin_bit_cast(int, s0), ln)) * w[j]; a1 += __builtin_bit_cast(float, __builtin_amdgcn_readlane(__builtin_bit_cast(int, s1), ln)) * w[j]; }
            }
            red[(F.wave * 2 + 0) * 64 + F.lane] = a0; red[(F.wave * 2 + 1) * 64 + F.lane] = a1;
            __syncthreads();
            if (F.wave < 2) { float s = 0.f;
#pragma unroll
                for (int w8 = 0; w8 < 8; ++w8) s += red[(w8 * 2 + F.wave) * 64 + F.lane];
                WSP(float, WS_MOD)[(size_t)(l * 2 + F.wave) * 6144 + col] = s + b_ada[(size_t)l * 6144 + col]; }
            __syncthreads();
        }
    }
    {
        const int gt = F.bid * 512 + F.tid, NT = F.G * 512;
        for (int i = gt; i < 256 * 16; i += NT) { const int pos = i >> 4, j = i & 15; const float inv = powf(10000.0f, -(float)(2 * j) / 32.0f);
            float s, c; sincosf((float)pos * inv, &s, &c); WSP(float, WS_ROPE)[2 * i] = c; WSP(float, WS_ROPE)[2 * i + 1] = s; }
        for (int i = gt; i < 64 * 64; i += NT) { float s, c; sincospif((float)(((i >> 6) * (i & 63)) & 63) / 32.0f, &s, &c); WSP(bf16, WS_FTAB)[i] = (bf16)f2bf(c); WSP(bf16, WS_FTAB)[4096 + i] = (bf16)f2bf(s); }
        for (int i = gt; i < 128 * 128; i += NT) { float s, c; sincospif((float)(((i >> 7) * (i & 127)) & 127) / 64.0f, &s, &c); WSP(bf16, WS_FTAB)[8192 + i] = (bf16)f2bf(c); WSP(bf16, WS_FTAB)[8192 + 16384 + i] = (bf16)f2bf(s); }
        for (int i = gt; i < 512; i += NT) WSP(unsigned, WS_F)[(size_t)T * 512 + i] = 0u;
        for (int i = gt; i < 2 * 16 * 1024; i += NT) { const int l = i >> 14, g = (i >> 10) & 15, k = i & 1023; WSP(float, WS_WGT)[i] = F.in[I_WIN][((size_t)l * D + k) * INW + 2560 + g]; }
        for (int i = gt; i < 2 * 32 * 1024; i += NT) { const int l = i >> 15, e = (i >> 10) & 31, k = i & 1023; WSP(float, WS_WRT)[i] = F.in[I_WR][((size_t)l * D + k) * NE + e]; }
    }
    {
        const int gw = F.bid * 8 + F.wave, NGW = F.G * 8;
        constexpr int PER_L = 16 * 72 + 16 * 16 + 16 * 32 + NE * (16 * 64) + NE * (16 * 32);
#pragma unroll 1
        for (int it = gw; it < 2 * PER_L; it += 4 * NGW) {
            const bool h1 = it + NGW < 2 * PER_L, h2 = it + 2 * NGW < 2 * PER_L, h3 = it + 3 * NGW < 2 * PER_L;
            const TItem ta = titem_decode(F, it, F.lane >> 3), tb = titem_decode(F, h1 ? it + NGW : it, F.lane >> 3), tc = titem_decode(F, h2 ? it + 2 * NGW : it, F.lane >> 3), td = titem_decode(F, h3 ? it + 3 * NGW : it, F.lane >> 3);
            f32x4 va[8], vb[8], vc[8], vd[8];
            titem_load(ta, F.lane, va); titem_load(tb, F.lane, vb); titem_load(tc, F.lane, vc); titem_load(td, F.lane, vd);
            titem_store(ta, va, F.lane); if (h1) titem_store(tb, vb, F.lane); if (h2) titem_store(tc, vc, F.lane); if (h3) titem_store(td, vd, F.lane);
        }
    }
}

template <int SRC, bool LAST>
__device__ __forceinline__ void row_phase(Frame& F, int l, const bool dry = false) {
    constexpr int ND = (SRC == 1) ? 32 : 16;
    const int lw = (SRC == 2) ? l + 1 : l;
    LAS float* wl = (LAS float*)F.lds;
    if (!LAST) {
        const float* wsrc = (SRC == 1) ? WSP(float, WS_WRT) + (size_t)l * 32 * D : WSP(float, WS_WGT) + (size_t)lw * 16 * D;
        for (int i = F.tid; i < ND * D / 4; i += 512) ((LAS f32x4*)wl)[i] = ((const f32x4*)wsrc)[i];
    }
    __syncthreads();
    const int row_lo = (l == 1 && SRC != 0) ? NCTX : 0;
    const int gw = F.bid * 8 + F.wave, NGW = F.G * 8;
    bf16* X = WSP(bf16, WS_X); bf16* Xo = dry ? WSP(bf16, WS_XG) : X; const int cl = dry ? l + 2 : l;
    float* gates_o = dry ? WSP(float, WS_YB) : WSP(float, WS_GATES); float* tokg_o = dry ? WSP(float, WS_YB + (2u << 20)) : WSP(float, WS_TOKG); int* elist_o = dry ? WSP(int, WS_YB + (4u << 20)) : WSP(int, WS_ELIST);
    if (SRC == 1) { if (F.tid < 32) F.MISC[256 + F.tid] = 0; __syncthreads(); }
    int it = -1;
    f32x4 pxa[4], pxb[4];
    v2u pya[16], pyb[16], pza[4], pzb[4]; int tsn[4] = {0, 0, 0, 0};
#define ROW_LOAD(rr, px, pz, py) do { const int r_ = (rr); if (SRC == 0) { const f32x4* s_ = (const f32x4*)(r_ < NCTX ? F.in[I_CTX] + (size_t)r_ * D : F.in[I_X] + (size_t)(r_ - NCTX) * D); \
            _Pragma("unroll") for (int j_ = 0; j_ < 4; ++j_) px[j_] = s_[F.lane + 64 * j_]; } \
        else if (SRC == 1) { const v2u* m_ = (const v2u*)(WSP(bf16, WS_MIX) + (size_t)r_ * D); \
            if (l == 0) { const f32x4* x_ = (const f32x4*)(r_ < NCTX ? F.in[I_CTX] + (size_t)r_ * D : F.in[I_X] + (size_t)(r_ - NCTX) * D); _Pragma("unroll") for (int j_ = 0; j_ < 4; ++j_) px[j_] = x_[F.lane + 64 * j_]; } \
            else { const v2u* x_ = (const v2u*)(X + (size_t)r_ * D); _Pragma("unroll") for (int j_ = 0; j_ < 4; ++j_) pz[j_] = x_[F.lane + 64 * j_]; } \
            _Pragma("unroll") for (int j_ = 0; j_ < 4; ++j_) py[j_] = m_[F.lane + 64 * j_]; } \
        else { const v2u* x_ = (const v2u*)(X + (size_t)r_ * D); \
            _Pragma("unroll") for (int j_ = 0; j_ < 4; ++j_) pz[j_] = x_[F.lane + 64 * j_]; \
            _Pragma("unroll") for (int k_ = 0; k_ < 4; ++k_) _Pragma("unroll") for (int j_ = 0; j_ < 4; ++j_) py[k_ * 4 + j_] = ((const v2u*)(WSP(bf16, WS_YB) + (size_t)tsn[k_] * D))[F.lane + 64 * j_]; \
            if (r_ + NGW < T) { _Pragma("unroll") for (int k_ = 0; k_ < 4; ++k_) tsn[k_] = WSP(int, WS_TSLOT)[(size_t)(r_ + NGW) * 4 + k_]; } } } while (0)
    if (SRC == 2 && row_lo + gw < T) {
#pragma unroll
        for (int k = 0; k < 4; ++k) tsn[k] = WSP(int, WS_TSLOT)[(size_t)(row_lo + gw) * 4 + k]; }
    if (row_lo + gw < T) ROW_LOAD(row_lo + gw, pxa, pza, pya);
    if (row_lo + gw + NGW < T) ROW_LOAD(row_lo + gw + NGW, pxb, pzb, pyb);
    auto body = [&](const int r, f32x4 (&px)[4], v2u (&pz)[4], v2u (&py)[16]) __attribute__((always_inline)) {
        ++it;
        const bool isctx = r < NCTX;
        const float* modv = WSP(float, WS_MOD) + (size_t)(l * 2 + (isctx ? 1 : 0)) * 6144;
        f32x4 v[4], cx[4], cf[4];
#pragma unroll
        for (int j = 0; j < 4; ++j) {
            if (SRC == 2 || (SRC == 1 && l != 0)) { const v2u q_ = pz[j]; cx[j] = (f32x4){bf_lo(q_.x), bf_hi(q_.x), bf_lo(q_.y), bf_hi(q_.y)}; }
            else cx[j] = px[j];
            if (SRC == 2) { f32x4 f_ = {0.f, 0.f, 0.f, 0.f};
#pragma unroll
                for (int k = 0; k < 4; ++k) { const v2u y_ = py[k * 4 + j]; f_[0] += bf_lo(y_.x); f_[1] += bf_hi(y_.x); f_[2] += bf_lo(y_.y); f_[3] += bf_hi(y_.y); }
                cf[j] = f_; } else if (SRC == 1) { const v2u y_ = py[j]; cf[j] = (f32x4){bf_lo(y_.x), bf_hi(y_.x), bf_lo(y_.y), bf_hi(y_.y)}; } else cf[j] = (f32x4){0.f, 0.f, 0.f, 0.f}; }
        if (r + 2 * NGW < T) ROW_LOAD(r + 2 * NGW, px, pz, py);
        if (SRC == 0) {
#pragma unroll
            for (int j = 0; j < 4; ++j) v[j] = cx[j];
        } else {
            const f32x4* gp = (const f32x4*)(modv + (SRC == 1 ? 2048 : 5120));
            f32x4 t[4]; float s = 0.f;
#pragma unroll
            for (int j = 0; j < 4; ++j) {
                f32x4 f;
                f = cf[j];
                t[j] = cx[j] * DN_ALPHA + gp[F.lane + 64 * j] * f;
                s += (t[j][0] + t[j][1]) + (t[j][2] + t[j][3]);
            }
            const float mean = wave_sum_u(s) * (1.f / D); float s2 = 0.f;
#pragma unroll
            for (int j = 0; j < 4; ++j) { t[j] = t[j] - mean; s2 += (t[j][0] * t[j][0] + t[j][1] * t[j][1]) + (t[j][2] * t[j][2] + t[j][3] * t[j][3]); }
            const float rstd = rsqrtf(wave_sum_u(s2) * (1.f / D) + LN_EPS);
            const f32x4* lw4 = (const f32x4*)(F.in[SRC == 1 ? I_LN1W : I_LN2W] + (size_t)l * D);
            const f32x4* lb4 = (const f32x4*)(F.in[SRC == 1 ? I_LN1B : I_LN2B] + (size_t)l * D);
#pragma unroll
            for (int j = 0; j < 4; ++j) v[j] = t[j] * rstd * lw4[F.lane + 64 * j] + lb4[F.lane + 64 * j];
        }
        if (LAST) {
            f32x4* o = (f32x4*)(F.out + (size_t)(r - NCTX) * D);
#pragma unroll
            for (int j = 0; j < 4; ++j) o[F.lane + 64 * j] = v[j];
            return;
        }
        if (SRC != 0) {
            v2u* o = (v2u*)(Xo + (size_t)r * D);
#pragma unroll
            for (int j = 0; j < 4; ++j) o[F.lane + 64 * j] = (v2u){pk2(v[j][0], v[j][1]), pk2(v[j][2], v[j][3])};
        }
        const float* modn = (SRC == 2) ? WSP(float, WS_MOD) + (size_t)(lw * 2 + (isctx ? 1 : 0)) * 6144 : modv;
        const f32x4* shp = (const f32x4*)(modn + (SRC == 1 ? 3072 : 0));
        const f32x4* scp = (const f32x4*)(modn + (SRC == 1 ? 4096 : 1024));
        bf16* hdst = (dry ? WSP(bf16, WS_ACT) : (SRC == 1 ? WSP(bf16, WS_F) : WSP(bf16, WS_H))) + (size_t)r * D;
        f32x4 h[4];
#pragma unroll
        for (int j = 0; j < 4; ++j) { h[j] = v[j] * (scp[F.lane + 64 * j] + 1.0f) + shp[F.lane + 64 * j];
            v2u w; w.x = pk2(h[j][0], h[j][1]); w.y = pk2(h[j][2], h[j][3]); ((v2u*)hdst)[F.lane + 64 * j] = w; }
        float pv[ND];
#pragma unroll
        for (int o = 0; o < ND; ++o) {
            f32x2 p2 = {0.f, 0.f};
#pragma unroll
            for (int j = 0; j < 4; ++j) { const f32x4 w = ((const LAS f32x4*)(wl + o * D))[F.lane + 64 * j];
                p2 = __builtin_elementwise_fma((f32x2){h[j][0], h[j][1]}, (f32x2){w[0], w[1]}, p2); p2 = __builtin_elementwise_fma((f32x2){h[j][2], h[j][3]}, (f32x2){w[2], w[3]}, p2); }
            pv[o] = p2[0] + p2[1];
            if ((o & 3) == 3) asm volatile("" ::: "memory");
        }
#define RS_SW32(n_) do { _Pragma("unroll") for (int i_ = 0; i_ < (n_); ++i_) { SWAP32(pv[i_], pv[i_ + (n_)]); pv[i_] += pv[i_ + (n_)]; } } while (0)
#define RS_SW16(n_) do { _Pragma("unroll") for (int i_ = 0; i_ < (n_); ++i_) { SWAP16(pv[i_], pv[i_ + (n_)]); pv[i_] += pv[i_ + (n_)]; } } while (0)
#define RS_SEL(n_, bit_) const bool up_ = (F.lane & (bit_)) != 0; const float snd_ = up_ ? pv[i_] : pv[i_ + (n_)], keep_ = up_ ? pv[i_ + (n_)] : pv[i_]
#define RS_D8(n_) do { _Pragma("unroll") for (int i_ = 0; i_ < (n_); ++i_) { RS_SEL(n_, 8); pv[i_] = keep_ + dpp0<0x128, 0xf, 0xf>(snd_); } } while (0)
#define RS_D4(n_) do { _Pragma("unroll") for (int i_ = 0; i_ < (n_); ++i_) { RS_SEL(n_, 4); pv[i_] = keep_ + dppo<0x114, 0xf, 0xa>(dpp0<0x104, 0xf, 0x5>(snd_), snd_); } } while (0)
#define RS_D2(n_) do { _Pragma("unroll") for (int i_ = 0; i_ < (n_); ++i_) { RS_SEL(n_, 2); pv[i_] = keep_ + dpp0<0x4E, 0xf, 0xf>(snd_); } } while (0)
        if constexpr (ND == 32) { RS_SW32(16); RS_SW16(8); RS_D8(4); RS_D4(2); RS_D2(1); pv[0] += dpp0<0xB1, 0xf, 0xf>(pv[0]); }
        else { RS_SW32(8); RS_SW16(4); RS_D8(2); RS_D4(1); pv[0] += dpp0<0x4E, 0xf, 0xf>(pv[0]); pv[0] += dpp0<0xB1, 0xf, 0xf>(pv[0]); }
#undef RS_SW32
#undef RS_SW16
#undef RS_SEL
#undef RS_D8
#undef RS_D4
#undef RS_D2
        const float mine = pv[0];
        if (SRC != 1) {
            if ((F.lane & 3) == 0) gates_o[(size_t)r * 16 + (F.lane >> 2)] = mine + F.in[I_GBIAS][lw * 16 + (F.lane >> 2)];
        } else {
            float val = ((F.lane & 1) == 0) ? mine + F.in[I_BR][l * 32 + (F.lane >> 1)] : -INFINITY;
            float tv[4]; int ti[4];
            int cnt = 0;
#pragma unroll
            for (int e = 0; e < 32; ++e) { const float se = __builtin_bit_cast(float, __builtin_amdgcn_readlane(__builtin_bit_cast(int, val), 2 * e)); cnt += (se > val) ? 1 : 0; }
            const bool evl = (F.lane & 1) == 0;
            const unsigned long long b0 = __builtin_amdgcn_ballot_w64(evl && cnt == 0), b1 = __builtin_amdgcn_ballot_w64(evl && cnt == 1), b2 = __builtin_amdgcn_ballot_w64(evl && cnt == 2), b3 = __builtin_amdgcn_ballot_w64(evl && cnt == 3);
            if (__builtin_popcountll(b0) == 1 && __builtin_popcountll(b1) == 1 && __builtin_popcountll(b2) == 1 && __builtin_popcountll(b3) == 1) {
                const int l0 = __builtin_ctzll(b0), l1 = __builtin_ctzll(b1), l2 = __builtin_ctzll(b2), l3 = __builtin_ctzll(b3);
                ti[0] = l0 >> 1; ti[1] = l1 >> 1; ti[2] = l2 >> 1; ti[3] = l3 >> 1;
                tv[0] = __builtin_bit_cast(float, __builtin_amdgcn_readlane(__builtin_bit_cast(int, val), l0)); tv[1] = __builtin_bit_cast(float, __builtin_amdgcn_readlane(__builtin_bit_cast(int, val), l1));
                tv[2] = __builtin_bit_cast(float, __builtin_amdgcn_readlane(__builtin_bit_cast(int, val), l2)); tv[3] = __builtin_bit_cast(float, __builtin_amdgcn_readlane(__builtin_bit_cast(int, val), l3));
            } else {
#pragma unroll 1
            for (int k = 0; k < 4; ++k) {
                float bv = val; int bi = F.lane >> 1;
#pragma unroll
                for (int off = 32; off >= 1; off >>= 1) { const float ov = shx(bv, F.lane, off); const int oi = shxi(bi, F.lane, off); if (ov > bv || (ov == bv && oi < bi)) { bv = ov; bi = oi; } }
                if (k == 0) { tv[0] = bv; ti[0] = bi; } else if (k == 1) { tv[1] = bv; ti[1] = bi; } else if (k == 2) { tv[2] = bv; ti[2] = bi; } else { tv[3] = bv; ti[3] = bi; }
                if ((F.lane >> 1) == bi) val = -INFINITY;
            }
            }
            const float e1 = __expf(tv[1] - tv[0]), e2 = __expf(tv[2] - tv[0]), e3 = __expf(tv[3] - tv[0]);
            const float inv = 1.0f / (1.0f + e1 + e2 + e3);
            if (F.lane < 4) {
                const int e = F.lane == 0 ? ti[0] : F.lane == 1 ? ti[1] : F.lane == 2 ? ti[2] : ti[3];
                const float g = (F.lane == 0 ? 1.0f : F.lane == 1 ? e1 : F.lane == 2 ? e2 : e3) * inv;
                const int lrank = __hip_atomic_fetch_add((LAS int*)(F.MISC + 256 + e), 1, __ATOMIC_RELAXED, __HIP_MEMORY_SCOPE_WORKGROUP);
                F.MISC[320 + (F.wave * 9 + it) * 4 + F.lane] = (e << 16) | lrank;
                tokg_o[(size_t)r * 4 + F.lane] = g;
            }
        }
    };
#pragma unroll 1
    for (int r = row_lo + gw; r < T; r += 2 * NGW) {
        body(r, pxa, pza, pya);
        if (r + NGW < T) body(r + NGW, pxb, pzb, pyb);
    }
    __syncthreads();
    if (SRC == 1) {
        if (F.tid < 32) { const int c = F.MISC[256 + F.tid];
            F.MISC[288 + F.tid] = c > 0 ? (int)__hip_atomic_fetch_add(WSP(unsigned, WS_CTL) + CW_CNT + (cl * 32 + F.tid) * 64, (unsigned)c, RLX_AGENT) : 0; }
        __syncthreads();
        int it2 = 0;
        for (int r = row_lo + gw; r < T; r += NGW, ++it2) {
            if (F.lane < 4) { const int pk = F.MISC[320 + (F.wave * 9 + it2) * 4 + F.lane]; const int e = pk >> 16, lr = pk & 0xffff;
                elist_o[(size_t)e * T + F.MISC[288 + e] + lr] = r * 4 + F.lane; }
        }
        __syncthreads();
    }
}

__device__ __forceinline__ void moe_prefix(Frame& F, int l, int npn) {
    if (F.wave == 0) {
        const int c = F.lane < 32 ? (int)__hip_atomic_load(WSP(unsigned, WS_CTL) + CW_CNT + (l * 32 + F.lane) * 64, RLX_AGENT) : 0; const int m = (c + 255) >> 8;
        const int b = (int)wave_scan_sum((float)m) - m;
        if (F.lane < 32) { F.MISC[F.lane] = b * npn; F.MISC[64 + F.lane] = m; F.MISC[128 + F.lane] = b; F.MISC[96 + F.lane] = c; }
        if (F.lane == 32) { F.MISC[32] = b * npn; F.MISC[128 + 32] = b; }
    }
    __syncthreads();
}
__device__ __forceinline__ void moe_gather(Frame& F, int l) {
    moe_prefix(F, l, 1);
    const int total_rows = F.MISC[128 + 32] * 256;
    for (int g = F.bid * 512 + F.tid; g < total_rows; g += F.G * 512) {
        const int tile = g >> 8; int e = 0;
#pragma unroll 1
        for (int j = 1; j < 32; ++j) e += (tile >= F.MISC[128 + j]) ? 1 : 0;
        const int s = (tile - F.MISC[128 + e]) * 256 + (g & 255);
        const int cnt = F.MISC[96 + e];
        int asg = -1; if (s < cnt) asg = WSP(int, WS_ELIST)[(size_t)e * T + s];
        WSP(int, WS_SROW)[g] = asg >= 0 ? (asg >> 2) : T;
        WSP(float, WS_SG)[g] = asg >= 0 ? WSP(float, WS_TOKG)[asg] : 0.f;
        if (asg >= 0) WSP(int, WS_TSLOT)[asg] = g;
    }
}

#ifndef ATT_FORCE8
#define ATT_FORCE8 0
#endif
constexpr int ATT_KS = 8192, ATT_VOFF = 24576, ATT_QOFF = 73728;
#define ATT_THR 8.0f
#define ATT_GLDS(src, dst) __builtin_amdgcn_global_load_lds((const unsigned*)(src), (LAS unsigned*)(dst), 16, 0, 0)
#define ATT_MFMA(a, b, c) __builtin_amdgcn_mfma_f32_32x32x16_bf16((a), (b), (c), 0, 0, 0)
typedef int v8i __attribute__((ext_vector_type(8)));
typedef unsigned v8u_t __attribute__((ext_vector_type(8)));
#define ATT_MFMA8X(a, b, c) __builtin_amdgcn_mfma_scale_f32_32x32x64_f8f6f4((a), (b), (c), 0, 0, 0, 0x7F7F7F7F, 0, 0x7F7F7F7F)
#define ATT_CAT8(lo, hi) __builtin_bit_cast(v8i, __builtin_shufflevector((lo), (hi), 0, 1, 2, 3, 4, 5, 6, 7))
#define ATT_ZERO16 ((f32x16){0.f, 0.f, 0.f, 0.f, 0.f, 0.f, 0.f, 0.f, 0.f, 0.f, 0.f, 0.f, 0.f, 0.f, 0.f, 0.f})
__device__ __forceinline__ void attn_qk0(const LAS unsigned char* kb, const v8i qf, int q, int hh, f32x16& S0, f32x16& S1) {
    const int pq = (q & ~12) | ((q & 4) << 1) | ((q & 8) >> 1);
    const int swk = (pq >> 2) & 3;
    const v4u a0l = *(const LAS v4u*)(kb + pq * 64 + (((2 * hh) ^ swk) * 16)), a0h = *(const LAS v4u*)(kb + pq * 64 + (((2 * hh + 1) ^ swk) * 16));
    const v4u a1l = *(const LAS v4u*)(kb + (32 + pq) * 64 + (((2 * hh) ^ swk) * 16)), a1h = *(const LAS v4u*)(kb + (32 + pq) * 64 + (((2 * hh + 1) ^ swk) * 16));
    S0 = ATT_MFMA8X(ATT_CAT8(a0l, a0h), qf, ATT_ZERO16); S1 = ATT_MFMA8X(ATT_CAT8(a1l, a1h), qf, ATT_ZERO16);
}
__device__ __forceinline__ void attn_pv(const LAS unsigned char* vb, const bf16x8 (&pf)[2][2], f32x16 (&O)[4], int q, int hh) {
    const int sw = (q >> 1) & 7;
#pragma unroll
    for (int d = 0; d < 4; ++d) { const LAS unsigned char* vrow = vb + (d * 32 + q) * 128;
#pragma unroll
        for (int f = 0; f < 4; ++f) { const int c16 = 2 * f + hh;
            O[d] = ATT_MFMA(*(const LAS bf16x8*)(vrow + ((c16 ^ sw) * 16)), pf[f >> 1][f & 1], O[d]); } }
}
#ifndef ATT_PF
#define ATT_PF 2
#endif
constexpr int att_use(bool ZERO, int f) { return f < 16 ? f : (ZERO ? 16 : 17) + ((f - 16) >> 1); }
constexpr int att_nw(bool ZERO, int g) { int n = 0; for (int f = 0; f < 20; ++f) { const int u = att_use(ZERO, f); if (u > g && u <= g + ATT_PF) ++n; } return n; }
template <class DMA>
__device__ __forceinline__ void attn_iter(const DMA& dma  , const bool dsel, const bool ZERO  , const bool FAST  , const LAS unsigned char* vb, const LAS unsigned char* kb, const v8i qf, f32x16& Sc0, f32x16& Sc1, f32x16& Sn0, f32x16& Sn1,
                                          bf16x8 (&pfp)[2][2], bf16x8 (&pfc)[2][2], f32x16 (&O)[4], float& m, float& lsum, bf16x8& bneg, const bool first, int q, int hh) {
    if (!ZERO && !FAST) {
    float mx = Sc0[0];
#pragma unroll
    for (int i = 1; i < 16; ++i) mx = fmaxf(mx, Sc0[i]);
#pragma unroll
    for (int i = 0; i < 16; ++i) mx = fmaxf(mx, Sc1[i]);
    mx = fmaxf(mx, shx(mx, q + 32 * hh, 32));
    if (first || !__all(mx <= ATT_THR)) {
        const float mnew = bf_lo(f2bf(m + (first ? mx : fmaxf(mx, 0.f)))); const float dm = mnew - m; const float alpha = first ? 0.f : __builtin_amdgcn_exp2f(-dm); m = mnew; lsum *= alpha;
        { v4u bn = {0u, 0u, 0u, 0u}; if (hh == 0) bn.x = f2bf(-m); bneg = __builtin_bit_cast(bf16x8, bn); }
#pragma unroll
        for (int i = 0; i < 16; ++i) { Sc0[i] -= dm; Sc1[i] -= dm; }
#pragma unroll
        for (int d = 0; d < 4; ++d)
#pragma unroll
            for (int i = 0; i < 16; ++i) O[d][i] *= alpha;
#pragma unroll
        for (int a = 0; a < 2; ++a)
#pragma unroll
            for (int b2 = 0; b2 < 2; ++b2) { v4u w = __builtin_bit_cast(v4u, pfp[a][b2]);
                w.x = pk2(bf_lo(w.x) * alpha, bf_hi(w.x) * alpha); w.y = pk2(bf_lo(w.y) * alpha, bf_hi(w.y) * alpha); w.z = pk2(bf_lo(w.z) * alpha, bf_hi(w.z) * alpha); w.w = pk2(bf_lo(w.w) * alpha, bf_hi(w.w) * alpha);
                pfp[a][b2] = __builtin_bit_cast(bf16x8, w); }
    }
    }
    __builtin_amdgcn_sched_barrier(0);
    const int sw = (q >> 1) & 7;
    float ps = 0.f; unsigned pw[16];
    bf16x8 fa[16]; v4u fk[4];
    const int pq = (q & ~12) | ((q & 4) << 1) | ((q & 8) >> 1), swk = (pq >> 2) & 3;
    unsigned vad[4], kad[2];
#pragma unroll
    for (int i = 0; i < 4; ++i) vad[i] = (unsigned)(size_t)(vb + q * 128 + (((2 * i + hh) ^ sw) * 16));
#pragma unroll
    for (int i = 0; i < 2; ++i) kad[i] = (unsigned)(size_t)(kb + pq * 64 + (((2 * hh + i) ^ swk) * 16));
#define ATT_LDFRAG(f) do { if ((f) < 16) asm volatile("ds_read_b128 %0, %1 offset:%2" : "=v"(fa[(f)]) : "v"(vad[(f) & 3]), "n"(((f) >> 2) * 4096)); \
        else asm volatile("ds_read_b128 %0, %1 offset:%2" : "=v"(fk[(f) - 16]) : "v"(kad[((f) - 16) & 1]), "n"((((f) - 16) >> 1) * 2048)); } while (0)
#ifndef ATT_PF
#define ATT_PF 2
#endif
#ifndef ATT_D0
#define ATT_D0 0
#endif
#ifndef ATT_D1
#define ATT_D1 8
#endif
    const int QK0 = ZERO ? 16 : 17, NS = QK0 + 2;
#define ATT_USE(f) ((f) < 16 ? (f) : QK0 + (((f) - 16) >> 1))
#pragma unroll
    for (int f = 0; f < 20; ++f) if (ATT_USE(f) - ATT_PF < 0) ATT_LDFRAG(f);
#pragma unroll
    for (int g = 0; g < NS; ++g) {
#pragma unroll
        for (int f = 0; f < 20; ++f) if (ATT_USE(f) - ATT_PF == g) ATT_LDFRAG(f);
        if (g == ATT_D0) { if (!dsel) dma(); }
        if (g == ATT_D1) { if (dsel) dma(); }
        if (g < 16) { asm volatile("s_waitcnt lgkmcnt(%1)" : "+v"(fa[g]) : "n"(att_nw(ZERO, g))); O[g >> 2] = ATT_MFMA(fa[g], pfp[(g & 3) >> 1][g & 1], O[g >> 2]); }
        else if (g < QK0) { v4u a1_ = {0u, 0u, 0u, 0u}; if (hh == 0) a1_.x = 0x3F80u; asm volatile("" : "+v"(a1_));
            Sn1 = ATT_MFMA(__builtin_bit_cast(bf16x8, a1_), bneg, ATT_ZERO16); }
        else if (g == QK0) { asm volatile("s_waitcnt lgkmcnt(%2)" : "+v"(fk[0]), "+v"(fk[1]) : "n"(att_nw(ZERO, g)));
            if (ZERO) Sn0 = ATT_MFMA8X(ATT_CAT8(fk[0], fk[1]), qf, ATT_ZERO16); else Sn0 = ATT_MFMA8X(ATT_CAT8(fk[0], fk[1]), qf, Sn1); }
        else { asm volatile("s_waitcnt lgkmcnt(%2)" : "+v"(fk[2]), "+v"(fk[3]) : "n"(att_nw(ZERO, g)));
            if (ZERO) Sn1 = ATT_MFMA8X(ATT_CAT8(fk[2], fk[3]), qf, ATT_ZERO16); else Sn1 = ATT_MFMA8X(ATT_CAT8(fk[2], fk[3]), qf, Sn1); }
        if (g < 16) {
#pragma unroll
            for (int e = 2 * g; e < 2 * g + 2; ++e) { float pe = __builtin_amdgcn_exp2f(e < 16 ? Sc0[e & 15] : Sc1[e & 15]); asm volatile("" : "+v"(pe)); ps += pe; if (e < 16) Sc0[e & 15] = pe; else Sc1[e & 15] = pe; }
        } else {
#pragma unroll
            for (int w = (16 * (g - 16)) / (NS - 16); w < (16 * (g - 15)) / (NS - 16); ++w) { pw[w] = (w < 8) ? pk2(Sc0[2 * w], Sc0[2 * w + 1]) : pk2(Sc1[2 * w - 16], Sc1[2 * w - 15]); }
        }
        __builtin_amdgcn_sched_barrier(0);
    }
#undef ATT_USE
#undef ATT_LDFRAG
    lsum += ps;
#pragma unroll
    for (int blk = 0; blk < 2; ++blk)
#pragma unroll
        for (int s2 = 0; s2 < 2; ++s2) pfc[blk][s2] = __builtin_bit_cast(bf16x8, (v4u){pw[8 * blk + 4 * s2 + 0], pw[8 * blk + 4 * s2 + 1], pw[8 * blk + 4 * s2 + 2], pw[8 * blk + 4 * s2 + 3]});
}
typedef short v2s16 __attribute__((ext_vector_type(2)));
#define ATT_MFMA8S(a, b, c, sb) __builtin_amdgcn_mfma_scale_f32_32x32x64_f8f6f4((a), (b), (c), 0, 0, 0, 0x7F7F7F7F, 0, (sb))
template <bool PRE  , bool NEXT  , class DMA>
__device__ __forceinline__ void attn_iter8(const DMA& dma, const bool dsel, const LAS unsigned char* vb, const LAS unsigned char* kb, const v8i qf, f32x16& Sc0, f32x16& Sc1, f32x16& Sn0, f32x16& Sn1,
                                           const v8i pfp, const int sfp, v8i& pfc, int& sfc, f32x16 (&O)[4], float& lsum, int q, int hh, const LAS unsigned char* vbn, v4u& f0, v4u& f1) {
    __builtin_amdgcn_sched_barrier(0);
    const int swv = (q >> 2) & 3;
    const int pq = (q & ~12) | ((q & 4) << 1) | ((q & 8) >> 1), swk = (pq >> 2) & 3;
    unsigned vad[2], kad[2];
#pragma unroll
    for (int i = 0; i < 2; ++i) { vad[i] = (unsigned)(size_t)(vb + q * 64 + (((2 * hh + i) ^ swv) * 16)); kad[i] = (unsigned)(size_t)(kb + pq * 64 + (((2 * hh + i) ^ swk) * 16)); }
    v4u fv[8], fk[4];
#define ATT_LD8(f) do { if ((f) < 8) asm volatile("ds_read_b128 %0, %1 offset:%2" : "=v"(fv[(f) & 7]) : "v"(vad[(f) & 1]), "n"(((f) >> 1) * 2048)); \
        else asm volatile("ds_read_b128 %0, %1 offset:%2" : "=v"(fk[((f) - 8) & 3]) : "v"(kad[(f) & 1]), "n"((((f) - 8) >> 1) * 2048)); } while (0)
    float ps = 0.f; unsigned pw[8]; float scf = 1.0f; int kb_ = 127;
    if (PRE) { fv[0] = f0; fv[1] = f1; } else { ATT_LD8(0); ATT_LD8(1); }
#pragma unroll
    for (int g = 0; g < 6; ++g) {
        if (g < 5) { ATT_LD8(2 * g + 2); ATT_LD8(2 * g + 3); }
        else if (NEXT) {
#pragma unroll
            for (int i = 0; i < 2; ++i) { const unsigned vn_ = (unsigned)(size_t)(vbn + q * 64 + (((2 * hh + i) ^ swv) * 16)); if (i == 0) asm volatile("ds_read_b128 %0, %1" : "=v"(f0) : "v"(vn_)); else asm volatile("ds_read_b128 %0, %1" : "=v"(f1) : "v"(vn_)); } }
        if (g == 0) dma();
        if (g < 4) { asm volatile("s_waitcnt lgkmcnt(2)" : "+v"(fv[(2 * g) & 7]), "+v"(fv[(2 * g + 1) & 7])); O[g & 3] = ATT_MFMA8S(ATT_CAT8(fv[(2 * g) & 7], fv[(2 * g + 1) & 7]), pfp, O[g & 3], sfp); }
        else if (g == 4) { asm volatile("s_waitcnt lgkmcnt(2)" : "+v"(fk[0]), "+v"(fk[1])); Sn0 = ATT_MFMA8X(ATT_CAT8(fk[0], fk[1]), qf, ATT_ZERO16); }
        else { if (NEXT) asm volatile("s_waitcnt lgkmcnt(2)" : "+v"(fk[2]), "+v"(fk[3])); else asm volatile("s_waitcnt lgkmcnt(0)" : "+v"(fk[2]), "+v"(fk[3])); Sn1 = ATT_MFMA8X(ATT_CAT8(fk[2], fk[3]), qf, ATT_ZERO16); }
        if (g < 4) {
#pragma unroll
            for (int e = 8 * g; e < 8 * g + 8; e += 2) {
                float p0 = __builtin_amdgcn_exp2f(e < 16 ? Sc0[e & 15] : Sc1[e & 15]), p1 = __builtin_amdgcn_exp2f(e < 16 ? Sc0[(e + 1) & 15] : Sc1[(e + 1) & 15]);
                asm volatile("" : "+v"(p0), "+v"(p1));
                ps += p0; ps += p1;
                if (e < 16) { Sc0[e & 15] = p0; Sc0[(e + 1) & 15] = p1; } else { Sc1[e & 15] = p0; Sc1[(e + 1) & 15] = p1; }
            }
        } else {
            if (g == 4) { kb_ = __builtin_amdgcn_frexp_expf(ps) + 119; scf = __builtin_bit_cast(float, kb_ << 23); }
#pragma unroll
            for (int w = 4 * (g - 4); w < 4 * (g - 4) + 4; ++w) {
                const float a0 = w < 4 ? Sc0[(4 * w) & 15] : Sc1[(4 * w) & 15], a1 = w < 4 ? Sc0[(4 * w + 1) & 15] : Sc1[(4 * w + 1) & 15], a2 = w < 4 ? Sc0[(4 * w + 2) & 15] : Sc1[(4 * w + 2) & 15], a3 = w < 4 ? Sc0[(4 * w + 3) & 15] : Sc1[(4 * w + 3) & 15];
                v2s16 r_ = __builtin_bit_cast(v2s16, pfc[w]);
                r_ = __builtin_amdgcn_cvt_scalef32_pk_fp8_f32(r_, a0, a1, scf, false); r_ = __builtin_amdgcn_cvt_scalef32_pk_fp8_f32(r_, a2, a3, scf, true);
                pw[w] = __builtin_bit_cast(unsigned, r_);
            }
        }
        __builtin_amdgcn_sched_barrier(0);
    }
#undef ATT_LD8
    lsum += ps; sfc = kb_;
    pfc = __builtin_bit_cast(v8i, (v8u_t){pw[0], pw[1], pw[2], pw[3], pw[4], pw[5], pw[6], pw[7]});
}
__device__ __forceinline__ void attn_pv8(const LAS unsigned char* vb, const v8i pf, const int sf, f32x16 (&O)[4], int q, int hh) {
    const int swv = (q >> 2) & 3;
#pragma unroll
    for (int d = 0; d < 4; ++d) { const LAS unsigned char* vrow = vb + (d * 32 + q) * 64;
        const v4u lo = *(const LAS v4u*)(vrow + (((2 * hh) ^ swv) * 16)), hi = *(const LAS v4u*)(vrow + (((2 * hh + 1) ^ swv) * 16));
        O[d] = ATT_MFMA8S(ATT_CAT8(lo, hi), pf, O[d], sf); }
}
template <int VAR>
__device__ __forceinline__ void attn_unit(Frame& F, int l, int head, int qt, int nkt, float lam, float oml) {
    const int wave = F.wave; int lane = F.lane; asm volatile("" : "+v"(lane));
    const int map = wave >> 2, q = lane & 31, hh = lane >> 5;
    const bf16* Q = WSP(bf16, WS_QB); const bf16* K = WSP(bf16, WS_KB); const bf16* VT = WSP(bf16, WS_VT);
    const int qrow = qt * 128 + (wave & 3) * 32 + q;
    float qn1 = 0.f;
    const unsigned char* Q8 = (const unsigned char*)Q; const unsigned char* K8 = (const unsigned char*)K;
    v8i qf;
    { const v4u q0 = *(const v4u*)(Q8 + ((size_t)(head * 2 + map) * T + qrow) * 64 + hh * 32), q1 = *(const v4u*)(Q8 + ((size_t)(head * 2 + map) * T + qrow) * 64 + hh * 32 + 16);
      qf = ATT_CAT8(q0, q1);
#define ATT_Q8SQ(w_, b_) { const float x_ = __builtin_amdgcn_cvt_f32_fp8((int)(w_), b_); qn1 += x_ * x_; }
#define ATT_Q8SQ4(w_) ATT_Q8SQ(w_, 0) ATT_Q8SQ(w_, 1) ATT_Q8SQ(w_, 2) ATT_Q8SQ(w_, 3)
      ATT_Q8SQ4(q0.x) ATT_Q8SQ4(q0.y) ATT_Q8SQ4(q0.z) ATT_Q8SQ4(q0.w) ATT_Q8SQ4(q1.x) ATT_Q8SQ4(q1.y) ATT_Q8SQ4(q1.z) ATT_Q8SQ4(q1.w)
#undef ATT_Q8SQ4
#undef ATT_Q8SQ
    }
    { int lq_ = lane; asm volatile("" : "+v"(lq_)); qn1 += shx(qn1, lq_, 32); }
    const unsigned* kq = WSP(unsigned, WS_CTL) + CW_KINF + l * 16 + (head * 2 + map) * 2;
    const float sbound = sqrtf(qn1 * (__uint_as_float(__hip_atomic_load(kq, RLX_AGENT)) + __uint_as_float(__hip_atomic_load(kq + 1, RLX_AGENT)))) * 1.08f;
    { unsigned z0_, z1_, z2_, z3_; asm volatile("v_mov_b32 %0, 0\n\tv_mov_b32 %1, 0\n\tv_mov_b32 %2, 0\n\tv_mov_b32 %3, 0" : "=v"(z0_), "=v"(z1_), "=v"(z2_), "=v"(z3_)); const v4u zz = {z0_, z1_, z2_, z3_};
      LAS v4u* z = (LAS v4u*)(F.lds + ATT_VOFF + 2 * 16384); z[F.tid] = zz; z[F.tid + 512] = zz; ((LAS v4u*)(F.lds + ATT_VOFF + 2 * 8192))[F.tid] = zz; }
    const bool zw = __all(sbound <= 60.0f) != 0; if (lane == 0) F.MISC[2000 + wave] = zw ? 1 : 0;
    f32x16 O[4];
#pragma unroll
    for (int d = 0; d < 4; ++d)
#pragma unroll
        for (int i = 0; i < 16; ++i) O[d][i] = 0.f;
    float m = 0.f, lsum = 0.f;
    bf16x8 bneg = (bf16x8){0, 0, 0, 0, 0, 0, 0, 0};
    const char* const sK1 = (const char*)(K8 + ((size_t)(head * 2 + (wave >> 2)) * T + (wave & 3) * 16) * 64);
    const unsigned oK = (unsigned)((lane >> 2) * 64 + (((lane & 3) ^ ((lane >> 4) & 3)) * 16));
#define ATT_OFFS() do {} while (0)
    LAS unsigned char* const wb = F.lds + wave * 1024;
#define ATT_LOADK(t, slot) do { const int kt_ = (t) < nkt ? (t) : nkt - 1; LAS unsigned char* b_ = wb + (slot) * ATT_KS; \
        ATT_GLDS(sK1 + (size_t)kt_ * 4096 + oK, b_); } while (0)
#define ATT_LOADV(t, slot) do { const int kt_ = (t) < nkt ? (t) : nkt - 1; LAS unsigned char* b_ = wb + ATT_VOFF + (slot) * 16384 + wave * 1024; \
        ATT_GLDS(sV0 + (size_t)kt_ * 128 + oV0, b_); ATT_GLDS(sV1 + (size_t)kt_ * 128 + oV1, b_ + 1024); } while (0)
#define ATT_SYNC(n) do { asm volatile("s_waitcnt vmcnt(" #n ")" ::: "memory"); __builtin_amdgcn_s_barrier(); asm volatile("" ::: "memory"); } while (0)
    if (wave >= 4) __builtin_amdgcn_s_setprio(1);
    f32x16 Sa0, Sa1, Sb0, Sb1; bf16x8 pfa[2][2], pfb[2][2];
#pragma unroll
    for (int i = 0; i < 2; ++i)
#pragma unroll
        for (int j = 0; j < 2; ++j) { pfa[i][j] = (bf16x8){0, 0, 0, 0, 0, 0, 0, 0}; pfb[i][j] = pfa[i][j]; }
    const LAS unsigned char* const kmap = F.lds + map * 4096; const LAS unsigned char* const vbase = F.lds + ATT_VOFF;
    ATT_LOADK(0, 0); ATT_LOADK(1, 1);
    ATT_SYNC(1);
    attn_qk0(kmap, qf, q, hh, Sa0, Sa1);
    __builtin_amdgcn_sched_barrier(0);
    bool zall = true;
#pragma unroll
    for (int w = 0; w < 8; ++w) zall = zall && (F.MISC[2000 + w] != 0);
    zall = __builtin_amdgcn_readfirstlane(zall ? 1 : 0) != 0;
#ifdef ATT_FORCE_BF16
    zall = false;
#endif
    float oscale = 1.0f;
    int s0 = 0;
    if (ATT_FORCE8 || zall) {
        const unsigned char* VT8 = (const unsigned char*)WSP(bf16, WS_XG);
        const char* const sV8 = (const char*)(VT8 + (size_t)(head * 128 + wave * 16) * T);
        int l8_ = lane; asm volatile("" : "+v"(l8_));
        const int q8 = l8_ & 31, h8 = l8_ >> 5;
        const unsigned oV8 = (unsigned)((l8_ >> 2) * T + (((l8_ & 3) ^ ((l8_ >> 4) & 3)) * 16));
#define ATT_LOADK4(t, slot) do { const int kt_ = (t) < nkt ? (t) : nkt - 1; ATT_GLDS(sK1 + (size_t)kt_ * 4096 + oK, wb + (slot) * ATT_KS); } while (0)
#define ATT_LOADV8(t, slot) do { const int kt_ = (t) < nkt ? (t) : nkt - 1; ATT_GLDS(sV8 + (size_t)kt_ * 64 + oV8, wb + 32768 + (slot) * 8192); } while (0)
        const LAS unsigned char* const vb8 = F.lds + 32768;
        v8i p8a = {0, 0, 0, 0, 0, 0, 0, 0}, p8b = p8a; int s8a = 127, s8b = 127; v4u nf0 = {0u, 0u, 0u, 0u}, nf1 = nf0;
        ATT_LOADK4(2, 2); ATT_LOADV8(0, 0);
#pragma unroll 2
        for (int j = 0; j < nkt; j += 2) {
            ATT_SYNC(0);
            { auto dma_ = [&]() { ATT_LOADK4(j + 3, (j + 3) & 3); ATT_LOADK4(j + 4, j & 3); ATT_LOADV8(j + 1, (j + 1) & 3); ATT_LOADV8(j + 2, (j + 2) & 3); };
              attn_iter8<false, true>(dma_, map != 0, vb8 + ((j + 3) & 3) * 8192, kmap + ((j + 1) & 3) * ATT_KS, qf, Sa0, Sa1, Sb0, Sb1, p8b, s8b, p8a, s8a, O, lsum, q8, h8, vb8 + (j & 3) * 8192, nf0, nf1); }
            { auto dma_ = [&]() {};
              attn_iter8<true, false>(dma_, map != 0, vb8 + (j & 3) * 8192, kmap + ((j + 2) & 3) * ATT_KS, qf, Sb0, Sb1, Sa0, Sa1, p8a, s8a, p8b, s8b, O, lsum, q8, h8, vb8, nf0, nf1); }
        }
        ATT_SYNC(0);
        attn_pv8(vb8 + ((nkt - 1) & 3) * 8192, p8b, s8b, O, q8, h8);
        ATT_SYNC(0);
        oscale = 0.25f;
#undef ATT_LOADV8
#undef ATT_LOADK4
    } else {
    int lb_ = lane; asm volatile("" : "+v"(lb_));
    const char* const sV0 = (const char*)(VT + (size_t)(head * 128 + wave * 16) * T);
    const char* const sV1 = (const char*)(VT + (size_t)(head * 128 + wave * 16 + 8) * T);
    const int r8 = lb_ >> 3, c8 = lb_ & 7; const unsigned oV0 = (unsigned)(r8 * T + ((c8 ^ (r8 >> 1)) * 8)) * 2u, oV1 = oV0 ^ 64u;
    ATT_LOADK(2, 2); ATT_LOADV(0, 0);
#define ATT_PAIR(ZEROV, FASTV, jj) do { const int j = (jj); const int s1 = s0 == 2 ? 0 : s0 + 1, s2 = s1 == 2 ? 0 : s1 + 1;    \
        ATT_SYNC(3);                                                        \
        { auto dma_ = [&]() { if (VAR != 1) { ATT_LOADK(j + 3, s0); ATT_LOADV(j + 1, s1); } }; \
          if (VAR != 2) attn_iter(dma_, map != 0, ZEROV, FASTV, vbase + s2 * 16384, kmap + s1 * ATT_KS, qf, Sa0, Sa1, Sb0, Sb1, pfb, pfa, O, m, lsum, bneg, j == 0, q, hh); else dma_(); }        \
        ATT_SYNC(3); \
        { auto dma_ = [&]() { if (VAR != 1) { ATT_LOADK(j + 4, s1); ATT_LOADV(j + 2, s2); } }; \
          if (VAR != 2) attn_iter(dma_, map != 0, ZEROV, FASTV, vbase + s0 * 16384, kmap + s2 * ATT_KS, qf, Sb0, Sb1, Sa0, Sa1, pfa, pfb, O, m, lsum, bneg, false, q, hh); else dma_(); }        \
        s0 = s2; } while (0)
    if (__all(sbound <= 60.0f) != 0) {
#pragma unroll 1
        for (int jj = 0; jj < nkt; jj += 2) ATT_PAIR(true, true, jj);
    } else {
        bool fast = false;
#pragma unroll 1
        for (int jj = 0; jj < nkt; jj += 2) {
            ATT_PAIR(false, fast, jj);
            if (jj == 0) fast = __all(sbound - m <= 60.0f) != 0;
        }
    }
#undef ATT_PAIR
    ATT_SYNC(0);
    if (VAR != 2) attn_pv(vbase + (s0 == 0 ? 2 : s0 - 1) * 16384, pfb, O, q, hh);
    ATT_SYNC(0);
    }
#undef ATT_LOADK
#undef ATT_LOADV
#undef ATT_SYNC
#undef ATT_OFFS
    __builtin_amdgcn_s_setprio(0);
    int lnE = lane; asm volatile("" : "+v"(lnE));
    const int qE = lnE & 31, hhE = lnE >> 5;
    const float inv = oscale / (lsum + shx(lsum, lnE, 32));
#pragma unroll
    for (int d = 0; d < 4; ++d)
#pragma unroll
        for (int i = 0; i < 16; ++i) O[d][i] *= inv;
    LAS float* X2 = (LAS float*)F.lds;
    LAS float* nwl = (LAS float*)(F.lds + 100352);
    { const int tE = wave * 64 + lnE; if (tE < 128) nwl[tE] = (F.in[I_DNW] + (size_t)l * 512 + head * 128)[tE]; }
    if (map == 1) {
#pragma unroll
        for (int d = 0; d < 4; ++d)
#pragma unroll
            for (int i = 0; i < 16; ++i) X2[((wave & 3) * 64 + d * 16 + i) * 64 + lnE] = O[d][i];
    }
    __syncthreads();
    LAS unsigned char* tile = F.lds + 65536 + (wave & 3) * 8704;
    if (map == 0) {
        float ss = 0.f;
#pragma unroll
        for (int d = 0; d < 4; ++d) {
            asm volatile("" ::: "memory");
#pragma unroll
            for (int i = 0; i < 16; ++i) { const float o = O[d][i] - lam * X2[((wave & 3) * 64 + d * 16 + i) * 64 + lnE]; O[d][i] = o; ss += o * o; } }
        ss += shx(ss, lnE, 32);
        const float r = rsqrtf(ss * (1.0f / 128.0f) + LN_EPS) * (1.0f - (l == 0 ? 0.2f : 0.35550906f));
        const LAS float* nw = nwl;
#pragma unroll
        for (int d = 0; d < 4; ++d) {
            asm volatile("" ::: "memory");
#pragma unroll
            for (int i = 0; i < 16; i += 2) {
                const int dv = d * 32 + (i & 3) + 8 * (i >> 2) + 4 * hhE;
                *(LAS unsigned*)(tile + qE * 272 + dv * 2) = pk2(O[d][i] * r * nw[dv], O[d][i + 1] * r * nw[dv + 1]);
            } }
    }
    __syncthreads();
    if (map == 0) {
        bf16* dst = (VAR ? WSP(bf16, WS_XG) : WSP(bf16, WS_AOUT)) + (size_t)(qt * 128 + wave * 32) * D + head * 128;
#pragma unroll
        for (int c = 0; c < 8; ++c) { const int idx = lnE + 64 * c, row = idx >> 4, ch = idx & 15;
            *(v4u*)(dst + (size_t)row * D + ch * 8) = *(const LAS v4u*)(tile + row * 272 + ch * 16); }
    }
    __syncthreads();
}

constexpr int FT_C128 = 0, FT_S128 = 34816, FT_C64 = 69632, FT_S64 = 78848, FT_DATA = 88064;
__device__ __forceinline__ void fft_tables128_w3(Frame& F) {
    const bf16* tab = WSP(bf16, WS_FTAB);
    if (F.wave >= 3) {
        for (int i = F.tid - 192; i < 2 * 128 * 16; i += 320) { const int m = i >> 11, r = (i >> 4) & 127, c = i & 15;
            *(LAS v4u*)(F.lds + (m ? FT_S128 : FT_C128) + r * 272 + c * 16) = *(const v4u*)(tab + 8192 + m * 16384 + r * 128 + c * 8); }
    }
}
__device__ __forceinline__ void fft_tables(Frame& F) {
    const bf16* tab = WSP(bf16, WS_FTAB);
    for (int i = F.tid; i < 2 * 64 * 8; i += 512) { const int m = i >> 9, r = (i >> 3) & 63, c = i & 7;
        *(LAS v4u*)(F.lds + (m ? FT_S64 : FT_C64) + r * 144 + c * 16) = *(const v4u*)(tab + m * 4096 + r * 64 + c * 8); }
    for (int i = F.tid; i < 2 * 128 * 16; i += 512) { const int m = i >> 11, r = (i >> 4) & 127, c = i & 15;
        *(LAS v4u*)(F.lds + (m ? FT_S128 : FT_C128) + r * 272 + c * 16) = *(const v4u*)(tab + 8192 + m * 16384 + r * 128 + c * 8); }
    __syncthreads();
}
__device__ __forceinline__ void fft_tab256(Frame& F) {
    LAS float* tab256 = (LAS float*)(F.lds + TAB_OFF);
    if (F.tid < 256) tab256[F.tid] = cospif((float)F.tid / 128.0f);
    __syncthreads();
}
__device__ __forceinline__ bf16x8 pack8(const f32x16& a, int s) {
    v4u w; w.x = pk2(a[8 * s + 0], a[8 * s + 1]); w.y = pk2(a[8 * s + 2], a[8 * s + 3]); w.z = pk2(a[8 * s + 4], a[8 * s + 5]); w.w = pk2(a[8 * s + 6], a[8 * s + 7]); return __builtin_bit_cast(bf16x8, w);
}
__device__ __forceinline__ void fft1_unit(Frame& F, int n2, int g) {
    const int tid = F.tid, wave = F.wave, lane = F.lane;
    const bf16* U = WSP(bf16, WS_MQ + 4 * SEGB);
    LAS unsigned char* ub = F.lds + FT_DATA;
#pragma unroll
    for (int i = 0; i < 2; ++i) { const int id = tid + 512 * i, r = id >> 3, c8 = id & 7;
        *(LAS v4u*)(ub + r * 144 + c8 * 16) = *(const v4u*)(U + (size_t)(NCTX + 128 * r + n2) * 256 + g * 64 + c8 * 8); }
    __syncthreads();
    const int rt = wave & 3, ct = wave >> 2, i = lane & 31, hh = lane >> 5;
    bf16x8 zP[4][2], zQ[4][2];
#pragma unroll
    for (int rr = 0; rr < 4; ++rr) {
        f32x16 aP, aQ;
#pragma unroll
        for (int j = 0; j < 16; ++j) { aP[j] = 0.f; aQ[j] = 0.f; }
#pragma unroll
        for (int s = 0; s < 4; ++s) {
            const bf16x8 a = *(const LAS bf16x8*)(ub + (rr * 32 + i) * 144 + (s * 16 + hh * 8) * 2);
            const bf16x8 bc = *(const LAS bf16x8*)(F.lds + FT_C64 + (ct * 32 + i) * 144 + (s * 16 + hh * 8) * 2), bs = *(const LAS bf16x8*)(F.lds + FT_S64 + (ct * 32 + i) * 144 + (s * 16 + hh * 8) * 2);
            aP = __builtin_amdgcn_mfma_f32_32x32x16_bf16(a, bc, aP, 0, 0, 0); aQ = __builtin_amdgcn_mfma_f32_32x32x16_bf16(a, bs, aQ, 0, 0, 0);
        }
        zP[rr][0] = pack8(aP, 0); zP[rr][1] = pack8(aP, 1); zQ[rr][0] = pack8(aQ, 0); zQ[rr][1] = pack8(aQ, 1);
    }
    f32x16 a1, a2, a3;
#pragma unroll
    for (int j = 0; j < 16; ++j) { a1[j] = 0.f; a2[j] = 0.f; a3[j] = 0.f; }
#pragma unroll
    for (int rr = 0; rr < 4; ++rr)
#pragma unroll
        for (int s = 0; s < 2; ++s) {
            const int kb = (rr * 32 + s * 16 + 4 * hh) * 2;
            const LAS unsigned char* rc = F.lds + FT_C128 + (rt * 32 + i) * 272 + kb; const LAS unsigned char* rs = F.lds + FT_S128 + (rt * 32 + i) * 272 + kb;
            const v2u cl = *(const LAS v2u*)rc, ch = *(const LAS v2u*)(rc + 16), sl = *(const LAS v2u*)rs, sh = *(const LAS v2u*)(rs + 16);
            const bf16x8 aC = __builtin_bit_cast(bf16x8, (v4u){cl.x, cl.y, ch.x, ch.y}), aS = __builtin_bit_cast(bf16x8, (v4u){sl.x, sl.y, sh.x, sh.y});
            a1 = __builtin_amdgcn_mfma_f32_32x32x16_bf16(aC, zP[rr][s], a1, 0, 0, 0); a2 = __builtin_amdgcn_mfma_f32_32x32x16_bf16(aS, zQ[rr][s], a2, 0, 0, 0);
            a3 = __builtin_amdgcn_mfma_f32_32x32x16_bf16(aC, zQ[rr][s], a3, 0, 0, 0); a3 = __builtin_amdgcn_mfma_f32_32x32x16_bf16(aS, zP[rr][s], a3, 0, 0, 0);
        }
    const int col = g * 64 + ct * 32 + i;
#pragma unroll
    for (int j = 0; j < 16; ++j) {
        const int ko = rt * 32 + (j & 3) + 8 * (j >> 2) + 4 * hh;
        const float Ar = a1[j] - a2[j], Ai = -a3[j];
        const float fr_ = (float)((n2 * ko) & 16383) * (1.0f / 16384.0f);
        const float s = __builtin_amdgcn_sinf(fr_), c = __builtin_amdgcn_cosf(fr_);
        WSP(float, WS_BRE)[(size_t)(ko * 128 + n2) * 256 + col] = Ar * c + Ai * s;
        WSP(float, WS_BIM)[(size_t)(ko * 128 + n2) * 256 + col] = Ai * c - Ar * s;
    }
    __syncthreads();
}
__device__ __forceinline__ void fft2_unit(Frame& F, int k1, int cb) {
    const int tid = F.tid, wave = F.wave, lane = F.lane;
    LAS unsigned char* zr = F.lds + FT_DATA; LAS unsigned char* zi = zr + 64 * 272;
#pragma unroll
    for (int i = 0; i < 4; ++i) { const int id = tid + 512 * i, r = id >> 4, c4 = id & 15;
        const f32x4 vr = *(const f32x4*)(WSP(float, WS_BRE) + (size_t)(k1 * 128 + r) * 256 + cb * 64 + c4 * 4), vi = *(const f32x4*)(WSP(float, WS_BIM) + (size_t)(k1 * 128 + r) * 256 + cb * 64 + c4 * 4);
#pragma unroll
        for (int j = 0; j < 4; ++j) { *(LAS bf16*)(zr + (c4 * 4 + j) * 272 + r * 2) = (bf16)f2bf(vr[j]); *(LAS bf16*)(zi + (c4 * 4 + j) * 272 + r * 2) = (bf16)f2bf(vi[j]); } }
    __syncthreads();
    const int rt = wave & 3, ct = wave >> 2, i = lane & 31, hh = lane >> 5;
    f32x16 acc;
#pragma unroll
    for (int j = 0; j < 16; ++j) acc[j] = 0.f;
#pragma unroll
    for (int s = 0; s < 8; ++s) {
        const int ko = (s * 16 + hh * 8) * 2;
        const bf16x8 aC = *(const LAS bf16x8*)(F.lds + FT_C128 + (rt * 32 + i) * 272 + ko), aS = *(const LAS bf16x8*)(F.lds + FT_S128 + (rt * 32 + i) * 272 + ko);
        const bf16x8 bR = *(const LAS bf16x8*)(zr + (ct * 32 + i) * 272 + ko), bI = *(const LAS bf16x8*)(zi + (ct * 32 + i) * 272 + ko);
        acc = __builtin_amdgcn_mfma_f32_32x32x16_bf16(aC, bR, acc, 0, 0, 0); acc = __builtin_amdgcn_mfma_f32_32x32x16_bf16(aS, bI, acc, 0, 0, 0);
    }
    const int col = cb * 64 + ct * 32 + i;
#pragma unroll
    for (int j = 0; j < 16; ++j) { const int ko = rt * 32 + (j & 3) + 8 * (j >> 2) + 4 * hh;
        WSP(bf16, WS_AOUT)[(size_t)(NCTX + k1 + 128 * ko) * D + 768 + col] = (bf16)f2bf(acc[j] * (1.0f / 1024.0f)); }
    __syncthreads();
}
__device__ __forceinline__ void fft_ctx_unit(Frame& F, int g, int ct) {
    const int tid = F.tid, wave = F.wave, lane = F.lane;
    LAS float* Us = (LAS float*)F.lds; LAS float* Pl = Us + 256 * 64; LAS float* Ql = Pl + 256 * 32; const LAS float* tab = (const LAS float*)(F.lds + TAB_OFF);
    const bf16* U = WSP(bf16, WS_MQ + 4 * SEGB);
#pragma unroll
    for (int j = 0; j < 8; ++j) { const int id = tid + 512 * j, r = id >> 4, c4 = id & 15;
        const v2u vv = *(const v2u*)(U + (size_t)r * 256 + g * 64 + c4 * 4); const f32x4 v = {bf_lo(vv.x), bf_hi(vv.x), bf_lo(vv.y), bf_hi(vv.y)};
#pragma unroll
        for (int e = 0; e < 4; ++e) { const int c = c4 * 4 + e; Us[r * 64 + ((c & 32) | ((c ^ r) & 31))] = v[e]; } }
    __syncthreads();
    const int i = lane & 31, kk = lane >> 5, kr = wave * 32 + i;
    {
        f32x16 aP, aQ;
#pragma unroll
        for (int j = 0; j < 16; ++j) { aP[j] = 0.f; aQ[j] = 0.f; }
#pragma unroll 4
        for (int t = 0; t < 32; ++t) { const int c = 2 * t + kk, idx = (c * (ct * 32 + i)) & 63;
            const float a = Us[kr * 64 + ((c & 32) | ((c ^ kr) & 31))];
            aP = __builtin_amdgcn_mfma_f32_32x32x2f32(a, tab[4 * idx], aP, 0, 0, 0); aQ = __builtin_amdgcn_mfma_f32_32x32x2f32(a, tab[(4 * idx + 192) & 255], aQ, 0, 0, 0); }
#pragma unroll
        for (int j = 0; j < 16; ++j) { const int r = wave * 32 + (j & 3) + 8 * (j >> 2) + 4 * kk; Pl[r * 32 + i] = aP[j]; Ql[r * 32 + i] = aQ[j]; }
    }
    __syncthreads();
    f32x16 a1, a2;
#pragma unroll
    for (int j = 0; j < 16; ++j) { a1[j] = 0.f; a2[j] = 0.f; }
    int idx0 = (kr * 8 * kk) & 255;
#pragma unroll 2
    for (int s = 0; s < 16; ++s) {
        unsigned ac[4], as[4], bp[4], bq[4];
#pragma unroll
        for (int j = 0; j < 8; j += 2) {
            const int m0 = (idx0 + kr * j) & 255, m1 = (m0 + kr) & 255, n0 = 16 * s + 8 * kk + j;
            ac[j >> 1] = pk2(tab[m0], tab[m1]); as[j >> 1] = pk2(tab[(m0 + 192) & 255], tab[(m1 + 192) & 255]);
            bp[j >> 1] = pk2(Pl[n0 * 32 + i], Pl[(n0 + 1) * 32 + i]); bq[j >> 1] = pk2(Ql[n0 * 32 + i], Ql[(n0 + 1) * 32 + i]);
        }
        a1 = __builtin_amdgcn_mfma_f32_32x32x16_bf16(__builtin_bit_cast(bf16x8, (v4u){ac[0], ac[1], ac[2], ac[3]}), __builtin_bit_cast(bf16x8, (v4u){bp[0], bp[1], bp[2], bp[3]}), a1, 0, 0, 0);
        a2 = __builtin_amdgcn_mfma_f32_32x32x16_bf16(__builtin_bit_cast(bf16x8, (v4u){as[0], as[1], as[2], as[3]}), __builtin_bit_cast(bf16x8, (v4u){bq[0], bq[1], bq[2], bq[3]}), a2, 0, 0, 0);
        idx0 = (idx0 + 16 * kr) & 255;
    }
#pragma unroll
    for (int j = 0; j < 16; ++j) {
        const int ko = wave * 32 + (j & 3) + 8 * (j >> 2) + 4 * kk;
        WSP(bf16, WS_AOUT)[(size_t)ko * D + 768 + g * 64 + ct * 32 + i] = (bf16)f2bf((a1[j] - a2[j]) * (1.0f / 128.0f));
    }
    __syncthreads();
}

__device__ __forceinline__ int ml_tc(int dir, int si) { return dir == 0 ? si : (si < 4 ? 3 - si : 263 - si); }
__device__ __forceinline__ int ml_row(int dir, int tc, int r) { return tc * 64 + (dir == 0 ? r : 63 - r); }
__device__ __forceinline__ void mlstm_a_phase(Frame& F) {
    const int wave = F.wave, lane = F.lane, dir = wave >> 2, wq = wave & 3, th = F.tid & 255;
    LAS float* ks = (LAS float*)(F.lds + dir * 49920); LAS float* wv = ks + 4160; LAS float* wl = wv + 4160;
    const float* gates = WSP(float, WS_GATES);
    const bf16* MK = WSP(bf16, WS_MQ + 1 * SEGB); const bf16* MV = WSP(bf16, WS_MQ + 2 * SEGB);
    v2u nku[4], nvu[4]; float nip = 0.f, nfp = 0.f;
#define MLA_LOAD(uu) do { const int head_ = (uu) & 3, tc_ = ml_tc(dir, (uu) >> 2); \
        _Pragma("unroll") for (int i = 0; i < 4; ++i) { const int id = th + 256 * i, r = id >> 4, c4 = id & 15; const size_t row = ml_row(dir, tc_, r); \
            nku[i] = *(const v2u*)(MK + row * 256 + head_ * 64 + c4 * 4); nvu[i] = *(const v2u*)(MV + row * 256 + head_ * 64 + c4 * 4); } \
        if (wq == 0) { const int row = ml_row(dir, tc_, lane); nip = gates[(size_t)row * 16 + dir * 4 + head_]; nfp = gates[(size_t)row * 16 + (2 + dir) * 4 + head_]; } } while (0)
    int u = F.bid;
    if (u < 4 * NCH) MLA_LOAD(u);
#pragma unroll 1
    for (; u < 4 * NCH; u += F.G) {
        const int head = u & 3, si = u >> 2;
        v2u ku[4], vu[4];
#pragma unroll
        for (int i = 0; i < 4; ++i) { ku[i] = nku[i]; vu[i] = nvu[i]; }
        const float ip = nip, fp = nfp;
        if (u + F.G < 4 * NCH) MLA_LOAD(u + F.G);
        float* CL = WSP(float, WS_CL) + ((size_t)(dir * 4 + head) * NCH + si) * 4160;
        if (wq == 0) {
            const float b = wave_scan_sum(logsigmoidf_(fp));
            const float g = __builtin_bit_cast(float, __builtin_amdgcn_readlane(__builtin_bit_cast(int, b), 63));
            const float a = g - b + ip;
            const float mloc = __builtin_bit_cast(float, __builtin_amdgcn_readlane(__builtin_bit_cast(int, wave_scan_max(a)), 63));
            wl[lane] = __expf(a - mloc);
            if (lane == 0) { float* sc = WSP(float, WS_SCAL) + ((size_t)(dir * 4 + head) * NCH + si) * 4; sc[0] = mloc; sc[1] = g; }
        }
        __syncthreads();
#pragma unroll
        for (int i = 0; i < 4; ++i) { const int id = th + 256 * i, r = id >> 4, c4 = id & 15;
            const f32x4 kv = {bf_lo(ku[i].x), bf_hi(ku[i].x), bf_lo(ku[i].y), bf_hi(ku[i].y)}, vv = {bf_lo(vu[i].x), bf_hi(vu[i].x), bf_lo(vu[i].y), bf_hi(vu[i].y)}; const float w = wl[r];
#pragma unroll
            for (int j = 0; j < 4; ++j) { ks[r * 65 + c4 * 4 + j] = kv[j]; wv[r * 65 + c4 * 4 + j] = vv[j] * w; } }
        __syncthreads();
        {
            const int vt = wq >> 1, kt = wq & 1, i = lane & 31, kk = lane >> 5;
            f32x16 acc;
#pragma unroll
            for (int j = 0; j < 16; ++j) acc[j] = 0.f;
#pragma unroll
            for (int s = 0; s < 4; ++s) {
                unsigned aw[4], bk[4];
#pragma unroll
                for (int j = 0; j < 8; j += 2) { const int t0 = 16 * s + 8 * kk + j;
                    aw[j >> 1] = pk2(wv[t0 * 65 + vt * 32 + i], wv[(t0 + 1) * 65 + vt * 32 + i]); bk[j >> 1] = pk2(ks[t0 * 65 + kt * 32 + i], ks[(t0 + 1) * 65 + kt * 32 + i]); }
                acc = __builtin_amdgcn_mfma_f32_32x32x16_bf16(__builtin_bit_cast(bf16x8, (v4u){aw[0], aw[1], aw[2], aw[3]}), __builtin_bit_cast(bf16x8, (v4u){bk[0], bk[1], bk[2], bk[3]}), acc, 0, 0, 0);
            }
#pragma unroll
            for (int j = 0; j < 16; ++j) { const int v = vt * 32 + (j & 3) + 8 * (j >> 2) + 4 * kk; CL[v * 64 + kt * 32 + i] = acc[j]; }
            if (wq == 0) { float n = 0.f;
                for (int r = 0; r < 64; ++r) n += wl[r] * ks[r * 65 + lane];
                CL[4096 + lane] = n; }
        }
        __syncthreads();
    }
#undef MLA_LOAD
}
__device__ __forceinline__ void mlstm_scan_wave(Frame& F, int item) {
    const int dh = item / 65, eg = item % 65, e = eg * 64 + F.lane;
    LAS float* sc = (LAS float*)(F.lds + 122880 + F.wave * 2112);
    float* SC = WSP(float, WS_SCAL) + (size_t)dh * NCH * 4;
    const float* src = WSP(float, WS_CL) + (size_t)dh * NCH * 4160 + e; float* dst = WSP(float, WS_C0) + (size_t)dh * NCH * 4160 + e;
    float xa[20], xb[20];
#define SCAN_LOAD(x_, s_) do { _Pragma("unroll") for (int j = 0; j < 20; ++j) x_[j] = src[(size_t)((s_) + j) * 4160]; } while (0)
    SCAN_LOAD(xa, 0);
    {
        float cM = 0.f;
#pragma unroll 1
        for (int b0 = 0; b0 < NCH; b0 += 64) {
            const int t = b0 + F.lane; const bool ok = t < NCH;
            f32x4 v = {0.f, 0.f, 0.f, 0.f}; if (ok) v = *(const f32x4*)(SC + t * 4);
            const float mloc = ok ? v[0] * 1.44269504089f : -INFINITY, g = ok ? v[1] * 1.44269504089f : 0.f;
            const float G = wave_scan_sum(g);
            const float P = fmaxf(cM, wave_scan_max(mloc - G));
            const float mt = G + P;
            float mprev = dpp0<0x138, 0xf, 0xf>(mt);
            if (F.lane == 0) mprev = cM;
            if (ok) { sc[2 * t] = __builtin_amdgcn_exp2f(g + mprev - mt); sc[2 * t + 1] = __builtin_amdgcn_exp2f(mloc - mt);
                if (eg == 0) SC[t * 4 + 2] = mprev * 0.69314718056f; }
            cM = __builtin_bit_cast(float, __builtin_amdgcn_readlane(__builtin_bit_cast(int, mt), 63));
        }
    }
    LDS_WAIT(); asm volatile("" ::: "memory");
    float C = 0.f;
#define SCAN_RUN(x_, s_) do { _Pragma("unroll") for (int j = 0; j < 20; ++j) { \
            const float e1 = sc[2 * ((s_) + j)], e2 = sc[2 * ((s_) + j) + 1]; \
            dst[(size_t)((s_) + j) * 4160] = C; \
            C = e1 * C + e2 * x_[j]; } } while (0)
#pragma unroll 1
    for (int s0 = 0; s0 < NCH; s0 += 40) {
        if (s0 + 20 < NCH) SCAN_LOAD(xb, s0 + 20);
        SCAN_RUN(xa, s0);
        if (s0 + 40 < NCH) SCAN_LOAD(xa, s0 + 40);
        if (s0 + 20 < NCH) SCAN_RUN(xb, s0 + 20);
    }
#undef SCAN_LOAD
#undef SCAN_RUN
}
constexpr int ML_ROWB = 144, ML_TILE = 64 * ML_ROWB, ML_DSZ = 4 * ML_TILE + 1280, ML_HS = 2 * ML_DSZ;
__device__ __forceinline__ void mlstm_out_phase(Frame& F, int l, int c_lo) {
    const int tid = F.tid, wave = F.wave, lane = F.lane, dir = wave >> 2, wq = wave & 3, th = tid & 255, i = lane & 31, hh = lane >> 5;
    LAS unsigned char* db = F.lds + dir * ML_DSZ;
    LAS unsigned char* qb = db; LAS unsigned char* kb = db + ML_TILE; LAS unsigned char* vt = db + 2 * ML_TILE; LAS unsigned char* cb = db + 3 * ML_TILE;
    LAS float* sm = (LAS float*)(db + 4 * ML_TILE); LAS float* bb = sm; LAS float* ib = sm + 64; LAS float* mr = sm + 128; LAS float* ei = sm + 192; LAS float* n0 = sm + 256;
    LAS float* hs = (LAS float*)(F.lds + ML_HS) + dir * 4160;
    const float* gates = WSP(float, WS_GATES);
    const bf16* MQ = WSP(bf16, WS_MQ); const bf16* MK = WSP(bf16, WS_MQ + 1 * SEGB); const bf16* MV = WSP(bf16, WS_MQ + 2 * SEGB); const bf16* MO = WSP(bf16, WS_MQ + 3 * SEGB);
    const int NU = 4 * (NCH - c_lo);
    v2u nq[4], nk[4], nv[4]; f32x4 nc[4]; float nip = 0.f, nfp = 0.f, nm0 = 0.f, nn0 = 0.f;
#define MLO_LOAD(uu) do { const int head_ = (uu) & 3, tc_ = c_lo + ((uu) >> 2); const int si_ = dir == 0 ? tc_ : (tc_ < 4 ? 3 - tc_ : 263 - tc_); const size_t sb_ = (size_t)(dir * 4 + head_) * NCH + si_; \
        _Pragma("unroll") for (int j4 = 0; j4 < 4; ++j4) { const int id = th + 256 * j4, r = id >> 4, c4 = id & 15; const size_t row = ml_row(dir, tc_, r); \
            nq[j4] = *(const v2u*)(MQ + row * 256 + head_ * 64 + c4 * 4); nk[j4] = *(const v2u*)(MK + row * 256 + head_ * 64 + c4 * 4); nv[j4] = *(const v2u*)(MV + row * 256 + head_ * 64 + c4 * 4); \
            nc[j4] = *(const f32x4*)(WSP(float, WS_C0) + sb_ * 4160 + r * 64 + c4 * 4); } \
        if (wq == 0) { const int row = ml_row(dir, tc_, lane); nip = gates[(size_t)row * 16 + dir * 4 + head_]; nfp = gates[(size_t)row * 16 + (2 + dir) * 4 + head_]; \
            nm0 = WSP(float, WS_SCAL)[sb_ * 4 + 2]; nn0 = WSP(float, WS_C0)[sb_ * 4160 + 4096 + lane]; } } while (0)
    int u = F.bid;
    if (u < NU) MLO_LOAD(u);
#pragma unroll 1
    for (; u < NU; u += F.G) {
        const int head = u & 3, tc = c_lo + (u >> 2);
        v2u cq[4], ck[4], cvv[4]; f32x4 cc[4];
#pragma unroll
        for (int j4 = 0; j4 < 4; ++j4) { cq[j4] = nq[j4]; ck[j4] = nk[j4]; cvv[j4] = nv[j4]; cc[j4] = nc[j4]; }
        const float ip = nip, fp = nfp, m0 = nm0, n0v = nn0;
        if (u + F.G < NU) MLO_LOAD(u + F.G);
        if (wq == 0) {
            const float b = wave_scan_sum(logsigmoidf_(fp));
            const float d = ip - b; const float pm = wave_scan_max(d);
            const float mrow = b + fmaxf(m0, pm);
            bb[lane] = b; ib[lane] = d; mr[lane] = mrow; ei[lane] = __expf(b + m0 - mrow);
            n0[lane] = n0v;
        }
#pragma unroll
        for (int j4 = 0; j4 < 4; ++j4) { const int id = th + 256 * j4, r = id >> 4, c4 = id & 15;
            const v2u qv = cq[j4], kv = ck[j4], vv = cvv[j4]; const f32x4 cv = cc[j4];
            *(LAS v2u*)(qb + r * ML_ROWB + c4 * 8) = qv;
            *(LAS v2u*)(kb + r * ML_ROWB + c4 * 8) = kv;
            *(LAS v2u*)(cb + r * ML_ROWB + c4 * 8) = (v2u){pk2(cv[0], cv[1]), pk2(cv[2], cv[3])};
            *(LAS bf16*)(vt + (c4 * 4 + 0) * ML_ROWB + r * 2) = (bf16)(vv.x & 0xffffu); *(LAS bf16*)(vt + (c4 * 4 + 1) * ML_ROWB + r * 2) = (bf16)(vv.x >> 16);
            *(LAS bf16*)(vt + (c4 * 4 + 2) * ML_ROWB + r * 2) = (bf16)(vv.y & 0xffffu); *(LAS bf16*)(vt + (c4 * 4 + 3) * ML_ROWB + r * 2) = (bf16)(vv.y >> 16); }
        const int te = tid >> 3, vge = (tid & 7) * 8; const size_t rowe = (size_t)tc * 64 + te;
        const v4u ou = *(const v4u*)(MO + rowe * 256 + head * 64 + vge);
        const f32x4 nwa = *(const f32x4*)(F.in[I_MNW] + (size_t)l * 256 + head * 64 + vge), nwb = *(const f32x4*)(F.in[I_MNW] + (size_t)l * 256 + head * 64 + vge + 4);
        __syncthreads();
        {
            const int vtile = wq >> 1, ttile = wq & 1, t = ttile * 32 + i;
            const float bt = bb[t], mt = mr[t], et = ei[t];
            bf16x8 pS[2][2]; float dsum = 0.f;
#pragma unroll
            for (int st = 0; st < 2; ++st) {
                f32x16 acc;
#pragma unroll
                for (int j = 0; j < 16; ++j) acc[j] = 0.f;
#pragma unroll
                for (int ks = 0; ks < 4; ++ks) {
                    const bf16x8 a = *(const LAS bf16x8*)(kb + (st * 32 + i) * ML_ROWB + (ks * 16 + hh * 8) * 2), b = *(const LAS bf16x8*)(qb + t * ML_ROWB + (ks * 16 + hh * 8) * 2);
                    acc = __builtin_amdgcn_mfma_f32_32x32x16_bf16(a, b, acc, 0, 0, 0);
                }
#pragma unroll
                for (int j = 0; j < 16; ++j) { const int s_ = st * 32 + (j & 3) + 8 * (j >> 2) + 4 * hh;
                    const float w = (s_ <= t) ? __expf(bt + ib[s_] - mt) : 0.f; acc[j] *= w; dsum += acc[j]; }
                pS[st][0] = pack8(acc, 0); pS[st][1] = pack8(acc, 1);
            }
            dsum += shx(dsum, lane, 32);
            f32x16 num, G;
#pragma unroll
            for (int j = 0; j < 16; ++j) { num[j] = 0.f; G[j] = 0.f; }
#pragma unroll
            for (int st = 0; st < 2; ++st)
#pragma unroll
                for (int s2 = 0; s2 < 2; ++s2) {
                    const LAS unsigned char* vr = vt + (vtile * 32 + i) * ML_ROWB + (st * 32 + s2 * 16 + 4 * hh) * 2;
                    const v2u lo = *(const LAS v2u*)vr, hi = *(const LAS v2u*)(vr + 16);
                    num = __builtin_amdgcn_mfma_f32_32x32x16_bf16(__builtin_bit_cast(bf16x8, (v4u){lo.x, lo.y, hi.x, hi.y}), pS[st][s2], num, 0, 0, 0);
                }
#pragma unroll
            for (int ks = 0; ks < 4; ++ks) {
                const bf16x8 a = *(const LAS bf16x8*)(cb + (vtile * 32 + i) * ML_ROWB + (ks * 16 + hh * 8) * 2), b = *(const LAS bf16x8*)(qb + t * ML_ROWB + (ks * 16 + hh * 8) * 2);
                G = __builtin_amdgcn_mfma_f32_32x32x16_bf16(a, b, G, 0, 0, 0);
            }
            float dn = 0.f;
#pragma unroll
            for (int c = 0; c < 8; ++c) { const v4u qv = *(const LAS v4u*)(qb + t * ML_ROWB + c * 16);
                dn += n0[c * 8 + 0] * bf_lo(qv.x) + n0[c * 8 + 1] * bf_hi(qv.x) + n0[c * 8 + 2] * bf_lo(qv.y) + n0[c * 8 + 3] * bf_hi(qv.y) + n0[c * 8 + 4] * bf_lo(qv.z) + n0[c * 8 + 5] * bf_hi(qv.z) + n0[c * 8 + 6] * bf_lo(qv.w) + n0[c * 8 + 7] * bf_hi(qv.w); }
            const float den = dsum + et * dn; const float rden = 1.0f / fmaxf(fabsf(den), __expf(-mt));
            const int tl = dir == 0 ? t : 63 - t;
#pragma unroll
            for (int j = 0; j < 16; ++j) { const int v = vtile * 32 + (j & 3) + 8 * (j >> 2) + 4 * hh; hs[tl * 65 + v] = (num[j] + et * G[j]) * rden; }
        }
        __syncthreads();
        {
            const LAS float* h0 = (const LAS float*)(F.lds + ML_HS); const LAS float* h1 = h0 + 4160;
            float x[8]; float ss = 0.f;
#pragma unroll
            for (int j = 0; j < 8; ++j) { x[j] = h0[te * 65 + vge + j] + h1[te * 65 + vge + j]; ss += x[j] * x[j]; }
            ss += dpp0<0xB1, 0xf, 0xf>(ss); ss += dpp0<0x4E, 0xf, 0xf>(ss); ss += dppo<0x114, 0xf, 0xa>(dpp0<0x104, 0xf, 0x5>(ss), ss);
            const float r = rsqrtf(ss * (1.0f / 64.0f) + LN_EPS);
            const float op[8] = {bf_lo(ou.x), bf_hi(ou.x), bf_lo(ou.y), bf_hi(ou.y), bf_lo(ou.z), bf_hi(ou.z), bf_lo(ou.w), bf_hi(ou.w)};
            const float nw[8] = {nwa[0], nwa[1], nwa[2], nwa[3], nwb[0], nwb[1], nwb[2], nwb[3]};
            float y[8];
#pragma unroll
            for (int j = 0; j < 8; ++j) y[j] = x[j] * r * nw[j] * sigmoidf_(op[j]);
            v4u w; w.x = pk2(y[0], y[1]); w.y = pk2(y[2], y[3]); w.z = pk2(y[4], y[5]); w.w = pk2(y[6], y[7]);
            *(v4u*)(WSP(bf16, WS_AOUT) + rowe * D + 512 + head * 64 + vge) = w;
        }
        __syncthreads();
    }
#undef MLO_LOAD
}

constexpr int N_PHASES = 1 + 11 * DEPTH;
__device__ __forceinline__ float lam_init_of(int l) { return l == 0 ? 0.2f : 0.35550906f; }

__global__ void __launch_bounds__(512, 2) mk_fwd(Args args) {
    extern __shared__ __attribute__((aligned(16))) unsigned char lds_raw[];
    Frame F;
    F.lds = (LAS unsigned char*)lds_raw;
    F.MISC = (volatile LAS int*)(F.lds + MISC_OFF);
    const int wave_s = __builtin_amdgcn_readfirstlane((int)threadIdx.x >> 6);
    F.tid = threadIdx.x; F.lane = F.tid & 63; F.wave = wave_s;
    F.G = gridDim.x; F.bid = blockIdx.x;
    F.ws = args.ws; F.in = args.in; F.out = args.out;
    for (int u = F.tid; u < 256; u += 512) F.MISC[u] = 0;
    __syncthreads();
#if MK_SINGLE
    XcdBarrier bar = xcd_barrier_post(WSP(unsigned, WS_CTL) + CW_BAR, (volatile LAS unsigned*)(F.MISC + 200));
#define GRID_BAR() do { PH_BEGIN(); xcd_barrier(bar, F.tid); } while (0)
#else
#define GRID_BAR() do {} while (0)
#endif
    const int lo = args.ph_lo, hi = args.ph_hi;
#ifndef ONLY_SP
#define ONLY_SP -1
#endif
#ifndef REP_P0
#define REP_P0 1
#endif
#ifndef ATT_PROBE
#define ATT_PROBE 0
#endif
#ifndef REP_ATT
#define REP_ATT 1
#endif
#ifndef REP_MLA
#define REP_MLA 1
#endif
#ifndef REP_F1
#define REP_F1 1
#endif
#ifndef REP_FM
#define REP_FM 1
#endif
#ifndef REP_SP3
#define REP_SP3 1
#endif
#ifndef REP_SP4
#define REP_SP4 1
#endif
#ifndef NULL_G8
#define NULL_G8 0
#endif
#ifndef NULL_G1
#define NULL_G1 0
#endif
#ifndef REP_G1
#define REP_G1 1
#endif
#ifndef REP_G5
#define REP_G5 1
#endif
#ifndef REP_G8
#define REP_G8 1
#endif
#ifndef REP_G9
#define REP_G9 1
#endif
#ifndef REP_GA
#define REP_GA 1
#endif
#ifndef SPV_G1A
#define SPV_G1A 1
#define SPV_G1B 1
#endif
#ifndef SPV_ATT
#define SPV_ATT 1
#define SPV_CTXF 1
#define SPV_FFT1 1
#define SPV_MLA 1
#endif
#define SP_ON(sp) (ONLY_SP < 0 || ONLY_SP == (sp))
#define PH_BEGIN() do { int w_ = wave_s; unsigned on_ = ~0u; asm volatile("" : "+s"(w_), "+s"(on_)); int t_ = w_ * 64 + (int)__builtin_amdgcn_mbcnt_hi(on_, __builtin_amdgcn_mbcnt_lo(on_, 0u)); asm volatile("" : "+v"(t_)); F.tid = t_; F.lane = t_ & 63; F.wave = w_; } while (0)
#ifndef REP_R0
#define REP_R0 1
#endif
#ifndef REP_R1
#define REP_R1 1
#endif
#ifndef REP_R2
#define REP_R2 1
#endif
#ifndef REP_R2L
#define REP_R2L 1
#endif
#ifndef REP_BAR
#define REP_BAR 1
#endif
#define PH_END(ph) do { if ((ph) + 1 < hi) { for (int rb_ = 0; rb_ < REP_BAR; ++rb_) GRID_BAR(); } } while (0)
    if (lo <= 0 && 0 < hi) { PH_BEGIN(); if (SP_ON(100)) { for (int rep = 0; rep < REP_P0; ++rep) { p0_prologue(F); __syncthreads(); } } PH_END(0); }
#pragma unroll 1
    for (int l = 0; l < DEPTH; ++l) {
        const int pb = 1 + 11 * l;
        if (l == 0 && lo <= pb + 0 && pb + 0 < hi) { PH_BEGIN(); if (SP_ON(0)) { for (int rep = 0; rep < REP_R0; ++rep) row_phase<0, false>(F, 0); } PH_END(pb + 0); }
        if (lo <= pb + 1 && pb + 1 < hi) { PH_BEGIN(); if (SP_ON(1)) {
                if (NULL_G1) { pg8::Gemm g{WSP(bf16, WS_H), WSP(bf16, WS_WIN) + (size_t)l * 2560 * D, T, 2304, D}; pg8::StaticOrder S; S.init(T, 2304, F.G, F.bid);
                  pg8::EpiNull E{WSP(float, WS_XG)};
                  pg8::gemm_phase<pg8::EpiNull, pg8::StaticOrder, true, true>(F.lds, g, S, E, F.tid);
                  __syncthreads(); PH_BEGIN(); }
                for (int rep = 0; rep < REP_G1; ++rep) {
                { pg8::Gemm g{WSP(bf16, WS_H), WSP(bf16, WS_WIN) + (size_t)l * 2560 * D, T, 2304, D, nullptr, WSP(bf16, WS_WV) + (size_t)l * 512 * D, WSP(bf16, WS_H)};
                  pg8::InProjOrder S0; S0.s1.init(T, 2304, F.G, F.bid); S0.s2.init(512, T, F.G, F.bid); S0.G = F.G; S0.c = F.bid;
                  if (F.wave < 4) {
                      pg8::Unit u_; const bool ok_ = S0.next(F.wave, u_);
                      if (F.lane == 0) { F.MISC[1024 + 4 * F.wave] = ok_ ? u_.pm : -1; F.MISC[1025 + 4 * F.wave] = ok_ ? u_.pn : 0; F.MISC[1026 + 4 * F.wave] = ok_ ? u_.ty : 0; } }
                  else if (F.lane == 0) { F.MISC[1024 + 4 * F.wave] = -1; }
                  __syncthreads();
                  pg8::ListOrder S{(const volatile LAS int*)F.MISC + 1024};
                  pg8::EpiInProjAll E{pg8::EpiInProj{WSP(bf16, WS_QB), WSP(bf16, WS_KB), WSP(float, WS_MQ), WSP(float, WS_ROPE), WSP(unsigned, WS_CTL) + CW_KINF + l * 16}, pg8::EpiVt{WSP(bf16, WS_VT), (unsigned char*)WSP(bf16, WS_XG)}};
                  pg8::gemm_phase<pg8::EpiInProjAll, pg8::ListOrder, true, true>(F.lds, g, S, E, F.tid); }
                __syncthreads();
                }
            } PH_END(pb + 1); }
        if (lo <= pb + 2 && pb + 2 < hi) { PH_BEGIN(); if (SP_ON(2)) {
                float lam;
                { const float* dl = F.in[I_DLAM] + (size_t)l * 256;
                  const float s1 = wave_sum(dl[F.lane] * dl[64 + F.lane], F.lane), s2 = wave_sum(dl[128 + F.lane] * dl[192 + F.lane], F.lane);
                  lam = expf(s1) - expf(s2) + lam_init_of(l); lam = __builtin_bit_cast(float, __builtin_amdgcn_readfirstlane(__builtin_bit_cast(int, lam))); }
                const float oml = 0.f;
                const int n_cx = (l == 0 ? 8 : 0), n_cd = (l == 0 ? 8 : 0);
                if (ATT_PROBE) {
#pragma unroll 1
                for (int u = F.bid; u < 512 + n_cx; u += F.G) { const bool lat = u < 512; const int v = lat ? u : u - 512; attn_unit<ATT_PROBE>(F, l, v & 3, (lat ? 2 : 0) + (v >> 2), lat ? NCH : 4, lam, oml); } }
                if (ATT_PROBE) { __syncthreads(); PH_BEGIN(); }
                if (SPV_ATT) for (int rep = 0; rep < REP_ATT; ++rep) {
#pragma unroll 1
                for (int u = F.bid; u < 512 + n_cx; u += F.G) { const bool lat = u < 512; const int v = lat ? u : u - 512; attn_unit<0>(F, l, v & 3, (lat ? 2 : 0) + (v >> 2), lat ? NCH : 4, lam, oml); } }
                for (int rep2 = 0; rep2 < REP_FM; ++rep2) {
                PH_BEGIN();
                fft_tab256(F);
                if (SPV_CTXF) {
#pragma unroll 1
                for (int u = F.bid - 8; u < n_cd; u += F.G) if (u >= 0) fft_ctx_unit(F, u >> 1, u & 1); }
                PH_BEGIN();
                if (SPV_FFT1) for (int rep4 = 0; rep4 < REP_F1; ++rep4) { fft_tables(F);
#pragma unroll 1
                for (int u = F.bid; u < 512; u += F.G) fft1_unit(F, u >> 2, u & 3); }
                PH_BEGIN();
                if (SPV_MLA) for (int rep3 = 0; rep3 < REP_MLA; ++rep3) {
                mlstm_a_phase(F); } }
            } PH_END(pb + 2); }
        if (lo <= pb + 3 && pb + 3 < hi) { PH_BEGIN(); if (SP_ON(3)) {
                for (int rep = 0; rep < REP_SP3; ++rep) {
                fft_tables128_w3(F);
                for (int it = F.wave * F.G + F.bid; it < 520; it += 8 * F.G) mlstm_scan_wave(F, it);
                __syncthreads();
#pragma unroll 1
                for (int u = F.bid; u < 512; u += F.G) fft2_unit(F, u >> 2, u & 3); }
            } PH_END(pb + 3); }
        if (lo <= pb + 4 && pb + 4 < hi) { PH_BEGIN(); if (SP_ON(4)) {
                const int c_lo = (l == 0) ? 0 : 4;
                for (int rep = 0; rep < REP_SP4; ++rep)
                mlstm_out_phase(F, l, c_lo);
            } PH_END(pb + 4); }
        if (lo <= pb + 5 && pb + 5 < hi) { PH_BEGIN(); if (SP_ON(5)) {
                const int r0 = (l == 0) ? 0 : NCTX;
                for (int rep = 0; rep < REP_G5; ++rep) {
                pg8::Gemm g{WSP(bf16, WS_AOUT) + (size_t)r0 * D, WSP(bf16, WS_WOUT) + (size_t)l * D * D, T - r0, D, D}; pg8::StaticOrder S0; S0.init(T - r0, D, F.G, F.bid);
                if (F.wave < 4) { pg8::Unit u_; const bool ok_ = S0.next(F.wave, u_);
                    if (F.lane == 0) { F.MISC[1024 + 4 * F.wave] = ok_ ? u_.pm : -1; F.MISC[1025 + 4 * F.wave] = ok_ ? u_.pn : 0; F.MISC[1026 + 4 * F.wave] = 0; } }
                else if (F.lane == 0) { F.MISC[1024 + 4 * F.wave] = -1; }
                __syncthreads();
                pg8::ListOrder S{(const volatile LAS int*)F.MISC + 1024};
                pg8::EpiBf16Plain E{WSP(bf16, WS_MIX) + (size_t)r0 * D, D};
                pg8::gemm_phase<pg8::EpiBf16Plain, pg8::ListOrder, true, true>(F.lds, g, S, E, F.tid);
                __syncthreads();
                }
            } PH_END(pb + 5); }
        if (lo <= pb + 6 && pb + 6 < hi) { PH_BEGIN(); if (SP_ON(6)) { for (int rep = 1; rep < REP_R1; ++rep) row_phase<1, false>(F, l, true); row_phase<1, false>(F, l); } PH_END(pb + 6); }
        if (lo <= pb + 7 && pb + 7 < hi) { PH_BEGIN(); if (SP_ON(7)) { for (int rep = 0; rep < REP_GA; ++rep) { moe_gather(F, l); __syncthreads(); } } PH_END(pb + 7); }
        if (lo <= pb + 8 && pb + 8 < hi) { PH_BEGIN(); if (SP_ON(8)) {
                if (NULL_G8) { moe_prefix(F, l, 8);
                  pg8::Gemm g{WSP(bf16, WS_F), WSP(bf16, WS_WGU) + (size_t)l * NE * 2048 * D, SLOT_ROWS, NE * 2048, D, WSP(int, WS_SROW)};
                  pg8::MoeOrder S{(const volatile LAS int*)F.MISC, (const volatile LAS int*)F.MISC + 64, (const volatile LAS int*)F.MISC + 128, 8, F.G, F.bid};
                  pg8::EpiNull E{WSP(float, WS_XG)};
                  pg8::gemm_phase<pg8::EpiNull, pg8::MoeOrder, true, true, true>(F.lds, g, S, E, F.tid);
                  __syncthreads(); PH_BEGIN(); }
                for (int rep = 0; rep < REP_G8; ++rep) {
                moe_prefix(F, l, 8);
                pg8::Gemm g{WSP(bf16, WS_F), WSP(bf16, WS_WGU) + (size_t)l * NE * 2048 * D, SLOT_ROWS, NE * 2048, D, WSP(int, WS_SROW)};
                pg8::MoeOrder S0{(const volatile LAS int*)F.MISC, (const volatile LAS int*)F.MISC + 64, (const volatile LAS int*)F.MISC + 128, 8, F.G, F.bid};
                if (F.tid < 16) { pg8::Unit u_; const bool ok_ = S0.next(F.tid, u_); F.MISC[1024 + 4 * F.tid] = ok_ ? u_.pm : -1; F.MISC[1025 + 4 * F.tid] = ok_ ? u_.pn : 0; F.MISC[1026 + 4 * F.tid] = 0; }
                __syncthreads();
                pg8::ListOrder S{(const volatile LAS int*)F.MISC + 1024};
                pg8::EpiSwiglu E{WSP(bf16, WS_ACT), F.in[I_BGU] + (size_t)l * NE * 2048};
                pg8::gemm_phase<pg8::EpiSwiglu, pg8::ListOrder, true, true, true>(F.lds, g, S, E, F.tid);
                __syncthreads();
                }
            } PH_END(pb + 8); }
        if (lo <= pb + 9 && pb + 9 < hi) { PH_BEGIN(); if (SP_ON(9)) {
                for (int rep = 0; rep < REP_G9; ++rep) {
                moe_prefix(F, l, 4);
                pg8::Gemm g{WSP(bf16, WS_ACT), WSP(bf16, WS_WDN) + (size_t)l * NE * D * D, SLOT_ROWS, NE * D, D};
                pg8::MoeOrder S0{(const volatile LAS int*)F.MISC, (const volatile LAS int*)F.MISC + 64, (const volatile LAS int*)F.MISC + 128, 4, F.G, F.bid};
                if (F.tid < 16) { pg8::Unit u_; const bool ok_ = S0.next(F.tid, u_); F.MISC[1024 + 4 * F.tid] = ok_ ? u_.pm : -1; F.MISC[1025 + 4 * F.tid] = ok_ ? u_.pn : 0; F.MISC[1026 + 4 * F.tid] = 0; }
                __syncthreads();
                pg8::ListOrder S{(const volatile LAS int*)F.MISC + 1024};
                pg8::EpiDown E{WSP(bf16, WS_YB), F.in[I_BD] + (size_t)l * NE * D, WSP(float, WS_SG)};
                pg8::gemm_phase<pg8::EpiDown, pg8::ListOrder, true, true>(F.lds, g, S, E, F.tid);
                __syncthreads();
                }
            } PH_END(pb + 9); }
        if (lo <= pb + 10 && pb + 10 < hi) { PH_BEGIN(); if (SP_ON(10)) { if (l == DEPTH - 1) { for (int rep = 0; rep < REP_R2L; ++rep) row_phase<2, true>(F, l); } else { for (int rep = 1; rep < REP_R2; ++rep) row_phase<2, false>(F, l, true); row_phase<2, false>(F, l); } } PH_END(pb + 10); }
    }
}

extern "C" void kernel_launch(void* const* d_in, const int* in_sizes, int n_in, void* d_out, int out_size, void* d_ws, size_t ws_size, hipStream_t stream) {
    static int grid = 0;
    if (grid == 0) {
        if (n_in != 22 || out_size != SEQ * D || ws_size < WS_END) { fprintf(stderr, "kernel_launch: unexpected shapes (n_in %d, out %d, ws %zu < %zu)\n", n_in, out_size, ws_size, (size_t)WS_END); grid = -1; return; }
        int dev = 0, cus = 0, per_cu = 0;
        if (hipGetDevice(&dev) != hipSuccess || hipDeviceGetAttribute(&cus, hipDeviceAttributeMultiprocessorCount, dev) != hipSuccess) { grid = -1; return; }
        if (hipFuncSetAttribute((const void*)mk_fwd, hipFuncAttributeMaxDynamicSharedMemorySize, LDS_BYTES) != hipSuccess) { fprintf(stderr, "kernel_launch: hipFuncSetAttribute failed\n"); grid = -1; return; }
        if (hipOccupancyMaxActiveBlocksPerMultiprocessor(&per_cu, (const void*)mk_fwd, 512, LDS_BYTES) != hipSuccess || per_cu < 1) { fprintf(stderr, "kernel_launch: occupancy query reports %d\n", per_cu); }
        (void)hipGetLastError();
        grid = cus;
    }
    if (grid < 0) return;
    (void)hipMemsetAsync((char*)d_ws + WS_CTL, 0, CTL_ZERO_BYTES, stream);
    Args a{};
    for (int i = 0; i < 22; ++i) a.in[i] = (const float*)d_in[i];
    a.out = (float*)d_out; a.ws = (unsigned char*)d_ws;
#if MK_SINGLE
    a.ph_lo = 0; a.ph_hi = N_PHASES;
    hipLaunchKernelGGL(mk_fwd, dim3(grid), dim3(512), LDS_BYTES, stream, a);
#else
    for (int ph = 0; ph < N_PHASES; ++ph) {
        if (ph == 12) continue;
        a.ph_lo = ph; a.ph_hi = ph + 1;
        hipLaunchKernelGGL(mk_fwd, dim3(grid), dim3(512), LDS_BYTES, stream, a);
    }
#endif
}
```
